# Optimizing an MI355X kernel written in HIP

```python
import math
import jax, jax.numpy as jnp
from jax import lax
import numpy as np

D_MODEL = 1024
BATCH = 4
SEQ = 8192
DEPTH = 2

PLE_DIM = 256
D_MIX_SSD = D_MODEL
D_MIX_CONV = D_MODEL
D_MIX = D_MIX_SSD + D_MIX_CONV
SSD_HEAD_DIM = 64
SSD_HEADS = D_MIX_SSD // SSD_HEAD_DIM
SSD_GROUPS = 2
HEADS_PER_GROUP = SSD_HEADS // SSD_GROUPS
D_STATE = 64
SSD_CONV_W = 4
CHUNK = 128
SSD_CONV_DIM = D_MIX_SSD + 2 * SSD_GROUPS * D_STATE
SC_CONV_W = 3
IN_SPLITS = [SSD_CONV_DIM, SSD_HEADS, D_MIX_SSD, D_MIX_CONV, D_MIX_CONV, D_MIX_CONV, D_MIX_CONV]
IN_COLS = sum(IN_SPLITS)
EPS = 1e-6

kernel_name = "hybrid_ssd_shortconv_parallel_heads"


def rmsnorm(x, w):
    xf = x.astype(jnp.float32)
    xf = xf * lax.rsqrt(jnp.mean(xf * xf, axis=-1, keepdims=True) + EPS)
    return (xf * w.astype(jnp.float32)).astype(x.dtype)


def causal_dwconv(u, w, b=None):
    k_w = w.shape[0]
    length = u.shape[1]
    up = jnp.pad(u, ((0, 0), (k_w - 1, 0), (0, 0)))
    y = up[:, 0:length] * w[0]
    for k in range(1, k_w):
        y = y + up[:, k:k + length] * w[k]
    if b is not None:
        y = y + b
    return y


def segsum(a):
    t = a.shape[-1]
    cs = jnp.cumsum(a, axis=-1)
    diff = cs[..., :, None] - cs[..., None, :]
    mask = jnp.tril(jnp.ones((t, t), dtype=bool))
    return jnp.where(mask, diff, -jnp.inf)


def ssd_chunked(x, dt, a, b_mat, c_mat, d_skip):
    bsz, length, _, _ = x.shape
    nc = length // CHUNK
    g, r, p, n = SSD_GROUPS, HEADS_PER_GROUP, SSD_HEAD_DIM, D_STATE
    xd = (x * dt[..., None]).reshape(bsz, nc, CHUNK, g, r, p)
    bc = b_mat.reshape(bsz, nc, CHUNK, g, n)
    cc = c_mat.reshape(bsz, nc, CHUNK, g, n)
    adt = (dt * a).reshape(bsz, nc, CHUNK, g, r).transpose(0, 3, 4, 1, 2)
    a_cs = jnp.cumsum(adt, axis=-1)
    decay_in = jnp.exp(segsum(adt))
    cb = jnp.einsum("bclgn,bcsgn->bgcls", cc, bc)
    y_diag = jnp.einsum("bgrcls,bcsgrp->bclgrp", cb[:, :, None] * decay_in, xd)
    decay_states = jnp.exp(a_cs[..., -1:] - a_cs).transpose(0, 3, 4, 1, 2)
    states = jnp.einsum("bclgn,bclgrp->bcgrpn", bc, xd * decay_states[..., None])
    init = jnp.zeros_like(states[:, :1])
    states = jnp.concatenate([init, states], axis=1)
    totals = jnp.pad(a_cs[..., -1], ((0, 0), (0, 0), (0, 0), (1, 0)))
    decay_chunk = jnp.exp(segsum(totals))
    new_states = jnp.einsum("bgrzc,bcgrpn->bzgrpn", decay_chunk, states)
    prev_states = new_states[:, :-1]
    decay_out = jnp.exp(a_cs).transpose(0, 3, 4, 1, 2)
    y_off = jnp.einsum("bclgn,bcgrpn->bclgrp", cc, prev_states) * decay_out[..., None]
    y = (y_diag + y_off).reshape(bsz, length, SSD_HEADS, p)
    return y + d_skip[:, None] * x


def hybrid_layer(x, p_i, norm_pre, norm_post, w_in, ssd_conv_w, ssd_conv_b, dt_bias,
                 a_log, d_skip, ssd_norm, sc_conv_w, w_out, w_ple_gate, w_ple_proj):
    bsz, length, _ = x.shape
    h = rmsnorm(x, norm_pre)
    proj = h @ w_in
    idx = list(np.cumsum(IN_SPLITS)[:-1])
    xbc, dt_raw, z_ssd, sc_h, sc_b, sc_c, z_sc = jnp.split(proj, idx, axis=-1)

    xbc = jax.nn.silu(causal_dwconv(xbc, ssd_conv_w, ssd_conv_b))
    xs, bm, cm = jnp.split(xbc, [D_MIX_SSD, D_MIX_SSD + SSD_GROUPS * D_STATE], axis=-1)
    xs = xs.reshape(bsz, length, SSD_HEADS, SSD_HEAD_DIM)
    bm = bm.reshape(bsz, length, SSD_GROUPS, D_STATE)
    cm = cm.reshape(bsz, length, SSD_GROUPS, D_STATE)
    dt = jax.nn.softplus(dt_raw + dt_bias)
    a = -jnp.exp(a_log)
    y_ssd = ssd_chunked(xs, dt, a, bm, cm, d_skip).reshape(bsz, length, D_MIX_SSD)
    yz = (y_ssd * jax.nn.silu(z_ssd)).reshape(bsz, length, SSD_GROUPS, D_MIX_SSD // SSD_GROUPS)
    y_ssd = rmsnorm(yz, ssd_norm.reshape(SSD_GROUPS, -1)).reshape(bsz, length, D_MIX_SSD)

    v = causal_dwconv(sc_c * sc_h, sc_conv_w)
    y_sc = sc_b * v * jax.nn.silu(z_sc)

    mix = jnp.concatenate([y_ssd, y_sc], axis=-1) @ w_out
    x = x + rmsnorm(mix, norm_post)

    gate = jax.nn.sigmoid(x @ w_ple_gate)
    return x + gate * (p_i @ w_ple_proj)


def setup_inputs(seed: int = 0) -> dict:
    key = jax.random.key(seed)
    ks = jax.random.split(key, 16)
    f32 = jnp.float32
    x = jax.random.normal(ks[0], (BATCH, SEQ, D_MODEL), f32)
    p = jax.random.normal(ks[1], (DEPTH, BATCH, SEQ, PLE_DIM), f32)
    norm_pre = 1.0 + 0.05 * jax.random.normal(ks[2], (DEPTH, D_MODEL), f32)
    norm_post = 1.0 + 0.05 * jax.random.normal(ks[3], (DEPTH, D_MODEL), f32)
    w_in = jax.random.normal(ks[4], (DEPTH, D_MODEL, IN_COLS), f32) * D_MODEL ** -0.5
    ssd_conv_w = jax.random.normal(ks[5], (DEPTH, SSD_CONV_W, SSD_CONV_DIM), f32) * SSD_CONV_W ** -0.5
    ssd_conv_b = 0.02 * jax.random.normal(ks[6], (DEPTH, SSD_CONV_DIM), f32)
    dt0 = jnp.exp(jax.random.uniform(ks[7], (DEPTH, SSD_HEADS), f32,
                                     math.log(1e-3), math.log(1e-1)))
    dt_bias = dt0 + jnp.log(-jnp.expm1(-dt0))
    a_log = jnp.log(jax.random.uniform(ks[8], (DEPTH, SSD_HEADS), f32, 1.0, 16.0))
    d_skip = 1.0 + 0.05 * jax.random.normal(ks[9], (DEPTH, SSD_HEADS), f32)
    ssd_norm = 1.0 + 0.05 * jax.random.normal(ks[10], (DEPTH, D_MIX_SSD), f32)
    sc_conv_w = jax.random.normal(ks[11], (DEPTH, SC_CONV_W, D_MIX_CONV), f32) * SC_CONV_W ** -0.5
    w_out = jax.random.normal(ks[12], (DEPTH, D_MIX, D_MODEL), f32) * D_MIX ** -0.5
    w_ple_gate = jax.random.normal(ks[13], (DEPTH, D_MODEL, D_MODEL), f32) * D_MODEL ** -0.5
    w_ple_proj = jax.random.normal(ks[14], (DEPTH, PLE_DIM, D_MODEL), f32) * (0.5 * PLE_DIM ** -0.5)
    return {"x": x, "p": p, "norm_pre": norm_pre, "norm_post": norm_post, "w_in": w_in,
            "ssd_conv_w": ssd_conv_w, "ssd_conv_b": ssd_conv_b, "dt_bias": dt_bias,
            "a_log": a_log, "d_skip": d_skip, "ssd_norm": ssd_norm, "sc_conv_w": sc_conv_w,
            "w_out": w_out, "w_ple_gate": w_ple_gate, "w_ple_proj": w_ple_proj}


def reference(x, p, norm_pre, norm_post, w_in, ssd_conv_w, ssd_conv_b, dt_bias, a_log,
              d_skip, ssd_norm, sc_conv_w, w_out, w_ple_gate, w_ple_proj):
    for i in range(DEPTH):
        x = hybrid_layer(x, p[i], norm_pre[i], norm_post[i], w_in[i], ssd_conv_w[i],
                         ssd_conv_b[i], dt_bias[i], a_log[i], d_skip[i], ssd_norm[i],
                         sc_conv_w[i], w_out[i], w_ple_gate[i], w_ple_proj[i])
    return x
```

```cpp
#include <hip/hip_runtime.h>
#include <hip/hip_cooperative_groups.h>
#include <cstdio>
namespace cg = cooperative_groups;

#define LAS __attribute__((address_space(3)))
typedef unsigned short bf16_t;
typedef short bf16x8 __attribute__((ext_vector_type(8)));
typedef float f32x4 __attribute__((ext_vector_type(4)));
typedef unsigned u32x4 __attribute__((ext_vector_type(4)));
typedef unsigned u32x2 __attribute__((ext_vector_type(2)));

constexpr int MTOK = 32768, DM = 1024, SEQ = 8192, NCH = 64  , PW = 4352  ;
constexpr int NIN = 6656;
constexpr float EPS = 1e-6f;
constexpr int COL_Z = 1280, COL_BZ = 2304, COL_HC = 3328;

constexpr size_t SZ_BTIN = (size_t)2 * NIN * 1024 * 2, SZ_BTOUT = (size_t)2 * 1024 * 2048 * 2, SZ_BTG = (size_t)2 * 1024 * 1024 * 2, SZ_BTP = (size_t)2 * 1024 * 256 * 2;
constexpr size_t OFF_BTIN = 0, OFF_BTOUT = OFF_BTIN + SZ_BTIN, OFF_BTG = OFF_BTOUT + SZ_BTOUT, OFF_BTP = OFF_BTG + SZ_BTG;
constexpr size_t OFF_PB = OFF_BTP + SZ_BTP, SZ_PB = (size_t)2 * MTOK * 256 * 2;
constexpr size_t OFF_XB = OFF_PB + SZ_PB, SZ_XB = (size_t)MTOK * 1024 * 2;
constexpr size_t OFF_SSQ = OFF_XB + SZ_XB, SZ_SSQ = (size_t)MTOK * 16 * 4;
constexpr size_t OFF_SSQ2 = OFF_SSQ + SZ_SSQ;
constexpr size_t OFF_DT = OFF_SSQ2 + SZ_SSQ;
constexpr size_t OFF_TOT = OFF_DT + SZ_SSQ, SZ_TOT = 4 * 64 * 16 * 4;
constexpr size_t OFF_BAR = OFF_TOT + SZ_TOT, SZ_BAR = 16384;
constexpr size_t OFF_PROJ = OFF_BAR + SZ_BAR, SZ_PROJ = (size_t)MTOK * PW * 2;
constexpr size_t OFF_PP = OFF_PROJ + SZ_PROJ, SZ_PP = (size_t)MTOK * 1024 * 2;
constexpr size_t OFF_ST = OFF_PP + SZ_PP, SZ_ST = (size_t)4 * 64 * 16 * 4096 * 2;
constexpr size_t WS_END = OFF_ST + SZ_ST;

constexpr int LDS_BYTES = 152576 + 16;

struct Params {
    const float* x; const float* p; const float* norm_pre; const float* norm_post; const float* w_in; const float* conv_w; const float* conv_b;
    const float* dt_bias; const float* a_log; const float* d_skip; const float* ssd_norm; const float* sc_w; const float* w_out; const float* w_g; const float* w_p;
    float* out; unsigned char* ws; int ph_lo, ph_hi;
};

typedef const __attribute__((address_space(4))) Params* KP;
__device__ __forceinline__ KP kernarg_params() { KP p = (KP)__builtin_amdgcn_kernarg_segment_ptr(); asm volatile("" : "+s"(p)); return p; }
__device__ __forceinline__ int opaque_nblk() { int g = (int)gridDim.x; asm volatile("" : "+s"(g)); return g; }
__device__ __forceinline__ int opaque_tid() { int t = threadIdx.x; asm volatile("" : "+v"(t)); return t; }
__device__ __forceinline__ unsigned cvt_pk_bf16(float lo, float hi) { unsigned r; asm volatile("v_cvt_pk_bf16_f32 %0, %1, %2" : "=v"(r) : "v"(lo), "v"(hi)); return r; }
__device__ __forceinline__ bf16_t f2bf(float f) { return (bf16_t)(cvt_pk_bf16(f, 0.f) & 0xffffu); }
__device__ __forceinline__ float bf2f(bf16_t b) { return __uint_as_float(((unsigned)b) << 16); }
__device__ __forceinline__ float bflo(unsigned w) { return __uint_as_float(w << 16); }
__device__ __forceinline__ float bfhi(unsigned w) { return __uint_as_float(w & 0xffff0000u); }
__device__ __forceinline__ float silu_f(float v) { return v * __builtin_amdgcn_rcpf(1.f + __expf(-v)); }
__device__ __forceinline__ float sigmoid_f(float v) { return __builtin_amdgcn_rcpf(1.f + __expf(-v)); }
__device__ __forceinline__ void sigmoid2(float a, float b, float& sa, float& sb) {
    const float ea = 1.f + __expf(fminf(-a, 40.f)), eb = 1.f + __expf(fminf(-b, 40.f)); const float r = __builtin_amdgcn_rcpf(ea * eb); sa = r * eb; sb = r * ea; }
__device__ __forceinline__ float softplus_f(float v) { return v > 20.f ? v : log1pf(__expf(v)); }
__device__ __forceinline__ bf16x8 pack8(const float (&v)[8]) {
    u32x4 w; w.x = cvt_pk_bf16(v[0], v[1]); w.y = cvt_pk_bf16(v[2], v[3]); w.z = cvt_pk_bf16(v[4], v[5]); w.w = cvt_pk_bf16(v[6], v[7]);
    return __builtin_bit_cast(bf16x8, w);
}
__device__ __forceinline__ void unpack8(u32x4 w, float (&v)[8]) {
    v[0] = bflo(w.x); v[1] = bfhi(w.x); v[2] = bflo(w.y); v[3] = bfhi(w.y); v[4] = bflo(w.z); v[5] = bfhi(w.z); v[6] = bflo(w.w); v[7] = bfhi(w.w);
}

namespace pg8 {
constexpr int BM = 256, BK = 64, HALF = 128, HTB = HALF * BK * 2, STAGE_BYTES = 8 * HTB, NXCD = 8, WGM = 8;
__host__ __device__ __forceinline__ int lds_byte(int r, int c) { const int st = (r >> 4) * 2 + (c >> 5), rr = r & 15, cc = c & 31, ob = rr * 64 + cc * 2; return st * 1024 + (ob ^ (((ob >> 9) & 1) << 5)); }
__host__ __device__ __forceinline__ void stage_rc(int b, int& R, int& C) { const int st = b / 1024, sb = b % 1024, swz = sb ^ (((sb >> 9) & 1) << 5); R = (st >> 1) * 16 + swz / 64; C = (st & 1) * 32 + (swz % 64) / 2; }
__host__ __device__ __forceinline__ int perm32(int rho) { const int n = rho >> 4, i = rho & 15; return 8 * (i >> 2) + 4 * n + (i & 3); }
struct Unit { int pm, pn; };
struct Gemm { const bf16_t* A; const bf16_t* Bt; int M, N, K, lda; };
struct StaticOrder {
    int nM, nN, nwg, G, c;
    __device__ void init(int M, int N, int G_, int c_) { nM = M / BM; nN = N / BM; nwg = nM * nN; G = G_; c = c_; }
    __device__ bool next(int i, Unit& u) const {
        const long L = (long)i * G + c; if (L >= nwg) return false;
        int wgid = (int)L; { const int q = nwg / NXCD, r = nwg % NXCD, xcd = wgid % NXCD, off = wgid / NXCD; wgid = (xcd < r ? xcd * (q + 1) : r * (q + 1) + (xcd - r) * q) + off; }
        const int nig = WGM * nN, gid = wgid / nig, fm = gid * WGM, gsz = (nM - fm) < WGM ? (nM - fm) : WGM;
        u.pm = fm + ((wgid % nig) % gsz); u.pn = (wgid % nig) / gsz; return true;
    }
};

template <class Epi>
__device__ __forceinline__ void gemm_phase(LAS unsigned char* lds, const Gemm g, const StaticOrder& S, const Epi& E) {
    const int tid = opaque_tid(), wid = __builtin_amdgcn_readfirstlane(tid >> 6), lane = tid & 63, wr = wid >> 2, wc = wid & 3, fr = lane & 15, fq = lane >> 4;
    const int K = g.K, nt = K / BK, lda = g.lda;
    unsigned voffA[2], voffB[2];
#pragma unroll
    for (int i = 0; i < 2; ++i) { int R, C; stage_rc(tid * 16 + i * 8192, R, C); const int Rb = Epi::PERM ? ((R & ~31) + perm32(R & 31)) : R;
        voffA[i] = (unsigned)(R * lda + C) * 2u; voffB[i] = (unsigned)(Rb * K + C) * 2u; }
    const size_t kstep = (size_t)(BK * 2);
    const size_t hstepA = (size_t)HALF * lda * 2, hstepB = (size_t)HALF * K * 2;
    const size_t tstepA = 2 * hstepA, tstepB = 2 * hstepB;
    const unsigned ldsw = (unsigned)wid * 1024u;
    const int aoff = lds_byte(wr * 64 + fr, fq * 8), boff = lds_byte(wc * 32 + fr, fq * 8);
#define PG8_SA(b, h) (((b) * 2 + (h)) * HTB)
#define PG8_SB(b, h) ((4 + (b) * 2 + (h)) * HTB)
#define PG8_STAGE(bufoff, gbase, voff) do { _Pragma("unroll") for (int _i = 0; _i < 2; ++_i) \
        __builtin_amdgcn_global_load_lds((const unsigned*)((const char*)(gbase) + (voff)[_i]), (LAS unsigned*)(lds + (bufoff) + ldsw + _i * 8192), 16, 0, 0); } while (0)
#define PG8_LDA(dst, b, h) do { _Pragma("unroll") for (int m = 0; m < 4; ++m) _Pragma("unroll") for (int k = 0; k < 2; ++k) dst[m][k] = *(const LAS bf16x8*)(lds + PG8_SA(b, h) + aoff + m * 2048 + k * 1024); } while (0)
#define PG8_LDB(dst, b, h) do { _Pragma("unroll") for (int n = 0; n < 2; ++n) _Pragma("unroll") for (int k = 0; k < 2; ++k) dst[n][k] = *(const LAS bf16x8*)(lds + PG8_SB(b, h) + boff + n * 2048 + k * 1024); } while (0)
#define PG8_MMA(ai, bj, At, Bt) do { __builtin_amdgcn_s_setprio(1); _Pragma("unroll") for (int m = 0; m < 4; ++m) _Pragma("unroll") for (int n = 0; n < 2; ++n) _Pragma("unroll") for (int k = 0; k < 2; ++k) \
        acc[ai][bj][m][n] = __builtin_amdgcn_mfma_f32_16x16x32_bf16(Bt[n][k], At[m][k], acc[ai][bj][m][n], 0, 0, 0); __builtin_amdgcn_s_setprio(0); } while (0)
#define PG8_WAIT_V(n) asm volatile("s_waitcnt vmcnt(" #n ")" ::: "memory")
#define PG8_WAIT_L(n) asm volatile("s_waitcnt lgkmcnt(" #n ")" ::: "memory")
#define PG8_BAR __builtin_amdgcn_s_barrier()
#define PG8_SCHED __builtin_amdgcn_sched_barrier(0)
    Unit cur, nxt; int ui = 0;
    if (!S.next(0, cur)) return;
    f32x4 acc[2][2][4][2];
#pragma unroll
    for (int a = 0; a < 2; ++a)
#pragma unroll
        for (int b = 0; b < 2; ++b)
#pragma unroll
            for (int m = 0; m < 4; ++m)
#pragma unroll
                for (int n = 0; n < 2; ++n) acc[a][b][m][n] = (f32x4){0.f, 0.f, 0.f, 0.f};
    bf16x8 At[4][2], B0[2][2], B1[2][2];
    const char* cA = (const char*)g.A + (size_t)cur.pm * tstepA; const char* cB = (const char*)g.Bt + (size_t)cur.pn * tstepB;
    LAS float* rsl = (LAS float*)(lds + STAGE_BYTES);
    PG8_STAGE(PG8_SB(0, 0), cB, voffB); PG8_STAGE(PG8_SA(0, 0), cA, voffA); PG8_STAGE(PG8_SB(0, 1), cB + hstepB, voffB); PG8_STAGE(PG8_SA(0, 1), cA + hstepA, voffA);
    if (wr == 1) PG8_BAR;
    PG8_WAIT_V(4); PG8_BAR;
    PG8_STAGE(PG8_SB(1, 0), cB + kstep, voffB); PG8_STAGE(PG8_SA(1, 0), cA + kstep, voffA); PG8_STAGE(PG8_SB(1, 1), cB + hstepB + kstep, voffB);
    PG8_WAIT_V(6); PG8_BAR;
    for (;;) {
        const bool has_next = S.next(ui + 1, nxt);
        const char* nA = has_next ? (const char*)g.A + (size_t)nxt.pm * tstepA : cA; const char* nB = has_next ? (const char*)g.Bt + (size_t)nxt.pn * tstepB : cB;
        for (int t = 0; t < nt; t += 2) {
            const bool last = (t == nt - 2);
            const char* a1 = cA + (size_t)(t + 1) * kstep;
            const char* a2 = last ? nA : cA + (size_t)(t + 2) * kstep; const char* b2 = last ? nB : cB + (size_t)(t + 2) * kstep;
            const char* a3 = a2 + kstep; const char* b3 = b2 + kstep;
            if (E.rowscale() && t == 0 && wid < 4) __builtin_amdgcn_global_load_lds((const unsigned*)(E.row_ptr() + cur.pm * 256 + tid), (LAS unsigned*)(rsl + (ui & 1) * 256 + wid * 64), 4, 0, 0);
            PG8_LDB(B0, 0, 0); PG8_SCHED; PG8_LDA(At, 0, 0); PG8_STAGE(PG8_SA(1, 1), a1 + hstepA, voffA);
            PG8_WAIT_L(8); PG8_BAR; PG8_WAIT_L(0); PG8_MMA(0, 0, At, B0); PG8_BAR; PG8_SCHED;
            PG8_LDB(B1, 0, 1); PG8_STAGE(PG8_SB(0, 0), b2, voffB);
            PG8_BAR; PG8_WAIT_L(0); PG8_MMA(0, 1, At, B1); PG8_BAR;
            PG8_LDA(At, 0, 1); PG8_STAGE(PG8_SA(0, 0), a2, voffA);
            PG8_BAR; PG8_WAIT_L(0); PG8_MMA(1, 0, At, B0); PG8_BAR; PG8_SCHED;
            PG8_STAGE(PG8_SB(0, 1), b2 + hstepB, voffB);
            PG8_WAIT_V(6); PG8_BAR; PG8_MMA(1, 1, At, B1); PG8_BAR;
            PG8_LDB(B0, 1, 0); PG8_SCHED; PG8_LDA(At, 1, 0); PG8_STAGE(PG8_SA(0, 1), a2 + hstepA, voffA);
            PG8_WAIT_L(8); PG8_BAR; PG8_WAIT_L(0); PG8_MMA(0, 0, At, B0); PG8_BAR; PG8_SCHED;
            PG8_LDB(B1, 1, 1); PG8_STAGE(PG8_SB(1, 0), b3, voffB);
            PG8_BAR; PG8_WAIT_L(0); PG8_MMA(0, 1, At, B1); PG8_BAR;
            PG8_LDA(At, 1, 1); PG8_STAGE(PG8_SA(1, 0), a3, voffA);
            PG8_BAR; PG8_WAIT_L(0); PG8_MMA(1, 0, At, B0); PG8_BAR; PG8_SCHED;
            PG8_STAGE(PG8_SB(1, 1), b3 + hstepB, voffB);
            PG8_WAIT_V(6); PG8_BAR; PG8_MMA(1, 1, At, B1); PG8_BAR;
        }
        E(acc, cur, wr, wc, fr, fq, rsl + (ui & 1) * 256);
        if (!has_next) break;
#pragma unroll
        for (int a = 0; a < 2; ++a)
#pragma unroll
            for (int b = 0; b < 2; ++b)
#pragma unroll
                for (int m = 0; m < 4; ++m)
#pragma unroll
                    for (int n = 0; n < 2; ++n) acc[a][b][m][n] = (f32x4){0.f, 0.f, 0.f, 0.f};
        cur = nxt; cA = nA; cB = nB; ++ui;
    }
    PG8_WAIT_V(0);
    if (wr == 0) PG8_BAR;
    PG8_BAR;
#undef PG8_SA
#undef PG8_SB
#undef PG8_STAGE
#undef PG8_LDA
#undef PG8_LDB
#undef PG8_MMA
#undef PG8_WAIT_V
#undef PG8_WAIT_L
#undef PG8_BAR
#undef PG8_SCHED
}
}
using pg8::Unit;

__device__ __forceinline__ void store8bf(bf16_t* p, f32x4 v0, f32x4 v1) {
    u32x4 w; w.x = cvt_pk_bf16(v0[0], v0[1]); w.y = cvt_pk_bf16(v0[2], v0[3]); w.z = cvt_pk_bf16(v1[0], v1[1]); w.w = cvt_pk_bf16(v1[2], v1[3]);
    *(u32x4*)p = w;
}
__device__ __forceinline__ void store8bf_nt(bf16_t* p, f32x4 v0, f32x4 v1) {
    u32x4 w; w.x = cvt_pk_bf16(v0[0], v0[1]); w.y = cvt_pk_bf16(v0[2], v0[3]); w.z = cvt_pk_bf16(v1[0], v1[1]); w.w = cvt_pk_bf16(v1[2], v1[3]);
    __builtin_nontemporal_store(w, (u32x4*)p);
}
struct Epi1 {
    static constexpr bool PERM = true;
    bf16_t* proj; float* dt; const float* ssq;
    __device__ __forceinline__ void operator()(const f32x4 (&acc)[2][2][4][2], const Unit& u, int wr, int wc, int fr, int fq, const LAS float* rsl) const {
        const int row0 = u.pm * 256 + wr * 64 + fr, pn = u.pn;
        float rs[2][4];
#pragma unroll
        for (int ai = 0; ai < 2; ++ai)
#pragma unroll
            for (int m = 0; m < 4; ++m) rs[ai][m] = rsl[wr * 64 + fr + ai * 128 + m * 16];
#pragma unroll
        for (int ai = 0; ai < 2; ++ai)
#pragma unroll
            for (int m = 0; m < 4; ++m) {
                const int row = row0 + ai * 128 + m * 16;
                const float rstd = rsqrtf(rs[ai][m] * (1.f / 1024.f) + EPS);
                bf16_t* rp = proj + (size_t)row * PW + wc * 32 + 8 * fq;
                if (pn < 9) {
#pragma unroll
                    for (int bj = 0; bj < 2; ++bj) store8bf_nt(rp + pn * 256 + bj * 128, acc[ai][bj][m][0] * rstd, acc[ai][bj][m][1] * rstd);
                } else if (pn < 17) {
                    f32x4 b0 = acc[ai][0][m][0] * rstd, b1 = acc[ai][0][m][1] * rstd, z0 = acc[ai][1][m][0] * rstd, z1 = acc[ai][1][m][1] * rstd;
#pragma unroll
                    for (int j = 0; j < 4; ++j) { float sa, sb; sigmoid2(z0[j], z1[j], sa, sb); b0[j] *= z0[j] * sa; b1[j] *= z1[j] * sb; }
                    store8bf_nt(rp + COL_BZ + (pn - 9) * 128, b0, b1);
                } else if (pn < 25) {
                    const float r2 = rstd * rstd;
                    store8bf_nt(rp + COL_HC + (pn - 17) * 128, acc[ai][0][m][0] * acc[ai][1][m][0] * r2, acc[ai][0][m][1] * acc[ai][1][m][1] * r2);
                } else if (wc == 0 && fq < 2) {
                    float* dp = dt + (size_t)row * 16 + 8 * fq;
                    *(f32x4*)dp = acc[ai][0][m][0] * rstd; *(f32x4*)(dp + 4) = acc[ai][0][m][1] * rstd;
                }
                if (m & 1) asm volatile("" ::: "memory");
            }
    }
};
struct EpiPlain {
    static constexpr bool PERM = true;
    bf16_t* O; int ldc;
    __device__ __forceinline__ void operator()(const f32x4 (&acc)[2][2][4][2], const Unit& u, int wr, int wc, int fr, int fq, const LAS float* rsl) const {
        const int row0 = u.pm * 256 + wr * 64 + fr, col0 = u.pn * 256 + wc * 32 + 8 * fq;
#pragma unroll
        for (int ai = 0; ai < 2; ++ai)
#pragma unroll
            for (int m = 0; m < 4; ++m) { bf16_t* rp = O + (size_t)(row0 + ai * 128 + m * 16) * ldc + col0;
#pragma unroll
                for (int bj = 0; bj < 2; ++bj) store8bf(rp + bj * 128, acc[ai][bj][m][0], acc[ai][bj][m][1]);
                if (m & 1) asm volatile("" ::: "memory"); }
    }
};
struct Epi2 {
    static constexpr bool PERM = true;
    bf16_t* O; float* ssq;
    __device__ __forceinline__ void operator()(const f32x4 (&acc)[2][2][4][2], const Unit& u, int wr, int wc, int fr, int fq, const LAS float* rsl) const {
        const int row0 = u.pm * 256 + wr * 64 + fr, col0 = u.pn * 256 + wc * 32 + 8 * fq;
#pragma unroll
        for (int ai = 0; ai < 2; ++ai)
#pragma unroll
            for (int m = 0; m < 4; ++m) { const int row = row0 + ai * 128 + m * 16; bf16_t* rp = O + (size_t)row * 1024 + col0; float s = 0.f;
#pragma unroll
                for (int bj = 0; bj < 2; ++bj) { const f32x4 v0 = acc[ai][bj][m][0], v1 = acc[ai][bj][m][1]; store8bf(rp + bj * 128, v0, v1);
#pragma unroll
                    for (int j = 0; j < 4; ++j) s += v0[j] * v0[j] + v1[j] * v1[j]; }
                s += __shfl_xor(s, 16); s += __shfl_xor(s, 32);
                if (fq == 0) atomicAdd(ssq + row, s);
                if (m & 1) asm volatile("" ::: "memory"); }
    }
};
struct Epi3 {
    static constexpr bool PERM = true;
    float* X; const bf16_t* pp; bf16_t* xb; float* ssq; const bf16_t* x1b;
    __device__ __forceinline__ void operator()(const f32x4 (&acc)[2][2][4][2], const Unit& u, int wr, int wc, int fr, int fq, const LAS float* rsl) const {
        const int row0 = u.pm * 256 + wr * 64 + fr, col0 = u.pn * 256 + wc * 32 + 8 * fq;
        u32x4 xr[2][2], pr[2][2];
#pragma unroll
        for (int bj = 0; bj < 2; ++bj) { const size_t off = (size_t)row0 * 1024 + col0 + bj * 128; xr[0][bj] = *(const u32x4*)(x1b + off); pr[0][bj] = *(const u32x4*)(pp + off); }
#pragma unroll
        for (int ai = 0; ai < 2; ++ai)
#pragma unroll
            for (int m = 0; m < 4; ++m) { const int row = row0 + ai * 128 + m * 16; float s = 0.f; const int bt = ai * 4 + m;
                if (bt < 7) { const int nrow = row0 + ((bt + 1) >> 2) * 128 + ((bt + 1) & 3) * 16;
#pragma unroll
                    for (int bj = 0; bj < 2; ++bj) { const size_t off = (size_t)nrow * 1024 + col0 + bj * 128; xr[(bt + 1) & 1][bj] = *(const u32x4*)(x1b + off); pr[(bt + 1) & 1][bj] = *(const u32x4*)(pp + off); } }
#pragma unroll
                for (int bj = 0; bj < 2; ++bj) { const size_t off = (size_t)row * 1024 + col0 + bj * 128;
                    float xv[8], pv[8]; unpack8(xr[bt & 1][bj], xv); unpack8(pr[bt & 1][bj], pv);
                    f32x4 x0 = (f32x4){xv[0], xv[1], xv[2], xv[3]}, x1 = (f32x4){xv[4], xv[5], xv[6], xv[7]};
                    const f32x4 g0 = acc[ai][bj][m][0], g1 = acc[ai][bj][m][1];
#pragma unroll
                    for (int j = 0; j < 4; ++j) { float sa, sb; sigmoid2(g0[j], g1[j], sa, sb); x0[j] += sa * pv[j]; x1[j] += sb * pv[4 + j]; s += x0[j] * x0[j] + x1[j] * x1[j]; }
                    if (xb) store8bf(xb + off, x0, x1);
                    else { *(f32x4*)(X + off) = x0; *(f32x4*)(X + off + 4) = x1; } }
                if (xb) { s += __shfl_xor(s, 16); s += __shfl_xor(s, 32); if (fq == 0) atomicAdd(ssq + row, s); }
                asm volatile("" ::: "memory"); }
    }
};

struct EpiAll {
    static constexpr bool PERM = true;
    int mode, layer; unsigned char* ws; float* out;
    __device__ __forceinline__ bool rowscale() const { return mode == 0; }
    __device__ __forceinline__ const float* row_ptr() const { return (const float*)(ws + OFF_SSQ); }
    __device__ __forceinline__ void operator()(const f32x4 (&acc)[2][2][4][2], const Unit& u, int wr, int wc, int fr, int fq, const LAS float* rsl) const {
        if (mode == 0) { const Epi1 e{(bf16_t*)(ws + OFF_PROJ), (float*)(ws + OFF_DT), (const float*)(ws + OFF_SSQ)}; e(acc, u, wr, wc, fr, fq, rsl); }
        else if (mode == 1) { const EpiPlain e{(bf16_t*)(ws + OFF_PP), 1024}; e(acc, u, wr, wc, fr, fq, rsl); }
        else if (mode == 2) { const Epi2 e{(bf16_t*)out, (float*)(ws + OFF_SSQ2)}; e(acc, u, wr, wc, fr, fq, rsl); }
        else { const Epi3 e{out, (const bf16_t*)(ws + OFF_PP), layer == 0 ? (bf16_t*)(ws + OFF_XB) : nullptr, (float*)(ws + OFF_SSQ), (const bf16_t*)(ws + OFF_PROJ)}; e(acc, u, wr, wc, fr, fq, rsl); }
    }
};

__device__ __forceinline__ void transpose_tile_wave(const float* src, int ld, int k0, int c0, int valid, const float* rs, bf16_t* dst, int ldd, int j0, int lane) {
    const float* sp = src + (size_t)k0 * ld + c0 + lane; const bool ok = lane < valid;
    bf16_t* dp = dst + (size_t)(j0 + lane) * ldd + k0;
    { float v[64];
#pragma unroll
        for (int i = 0; i < 64; ++i) v[i] = ok ? sp[(size_t)i * ld] : 0.f;
        if (rs) {
#pragma unroll
            for (int i = 0; i < 64; ++i) v[i] *= rs[k0 + i]; }
#pragma unroll
        for (int o = 0; o < 8; ++o) { u32x4 w; w.x = cvt_pk_bf16(v[o * 8 + 0], v[o * 8 + 1]); w.y = cvt_pk_bf16(v[o * 8 + 2], v[o * 8 + 3]); w.z = cvt_pk_bf16(v[o * 8 + 4], v[o * 8 + 5]); w.w = cvt_pk_bf16(v[o * 8 + 6], v[o * 8 + 7]);
            *(u32x4*)(dp + o * 8) = w; } }
}
__device__ void phase_prologue(KP P, LAS unsigned char* lds) {
    unsigned char* ws = P->ws; (void)lds;
    const int tid = opaque_tid(), lane = tid & 63;
    const int gw = blockIdx.x * 8 + (tid >> 6), nw = opaque_nblk() * 8;
    for (int job = gw; job < 4992; job += nw) {
        if (job < 3328) { const int l = job / 1664, r = job % 1664, jt = r >> 4, kt = r & 15, j0 = jt * 64; int src, valid = 64;
            if (j0 < 1280) src = j0;
            else if (j0 < 2304) src = 1296 + (j0 - 1280);
            else if (j0 < 4352) { const int i = (j0 - 2304) >> 8, w = (j0 - 2304) & 255; src = (w < 128) ? 3344 + 128 * i + w : 5392 + 128 * i + (w - 128); }
            else if (j0 < 6400) { const int i = (j0 - 4352) >> 8, w = (j0 - 4352) & 255; src = (w < 128) ? 2320 + 128 * i + w : 4368 + 128 * i + (w - 128); }
            else if (j0 == 6400) { src = 1280; valid = 16; }
            else { src = 0; valid = 0; }
            transpose_tile_wave(P->w_in + (size_t)l * 1024 * 6416, 6416, kt * 64, src, valid, P->norm_pre + l * 1024, (bf16_t*)(ws + OFF_BTIN) + (size_t)l * NIN * 1024, 1024, j0, lane);
        } else if (job < 4352) { const int q = job - 3328, l = q >> 9, r = q & 511, ntile = r >> 5, kt = r & 31;
            transpose_tile_wave(P->w_out + (size_t)l * 2048 * 1024, 1024, kt * 64, ntile * 64, 64, nullptr, (bf16_t*)(ws + OFF_BTOUT) + (size_t)l * 1024 * 2048, 2048, ntile * 64, lane);
        } else if (job < 4864) { const int q = job - 4352, l = q >> 8, r = q & 255, ntile = r >> 4, kt = r & 15;
            transpose_tile_wave(P->w_g + (size_t)l * 1024 * 1024, 1024, kt * 64, ntile * 64, 64, nullptr, (bf16_t*)(ws + OFF_BTG) + (size_t)l * 1024 * 1024, 1024, ntile * 64, lane);
        } else { const int q = job - 4864, l = q >> 6, r = q & 63, ntile = r >> 2, kt = r & 3;
            transpose_tile_wave(P->w_p + (size_t)l * 256 * 1024, 1024, kt * 64, ntile * 64, 64, nullptr, (bf16_t*)(ws + OFF_BTP) + (size_t)l * 1024 * 256, 256, ntile * 64, lane);
        }
    }
    bf16_t* xb = (bf16_t*)(ws + OFF_XB); float* ssq = (float*)(ws + OFF_SSQ);
#pragma unroll 8
    for (int row = gw; row < MTOK; row += nw) { float s = 0.f;
#pragma unroll
        for (int i = 0; i < 4; ++i) { const int col = lane * 4 + 256 * i; const f32x4 v = *(const f32x4*)(P->x + (size_t)row * 1024 + col);
            s += v.x * v.x + v.y * v.y + v.z * v.z + v.w * v.w; u32x2 w; w.x = cvt_pk_bf16(v.x, v.y); w.y = cvt_pk_bf16(v.z, v.w); *(u32x2*)(xb + (size_t)row * 1024 + col) = w; }
#pragma unroll
        for (int d = 32; d >= 1; d >>= 1) s += __shfl_xor(s, d);
        if (lane == 0) ssq[row] = s; }
    bf16_t* pb = (bf16_t*)(ws + OFF_PB);
#pragma unroll 16
    for (size_t i = (size_t)blockIdx.x * 512 + tid; i < (size_t)2 * MTOK * 256 / 4; i += (size_t)nw * 64) {
        const f32x4 v = *(const f32x4*)(P->p + i * 4); u32x2 w; w.x = cvt_pk_bf16(v.x, v.y); w.y = cvt_pk_bf16(v.z, v.w); *(u32x2*)(pb + i * 4) = w; }
}

__device__ __forceinline__ void conv8_nat(const bf16_t* proj, long row0, int tbase, int l, int ch, const float* cw, const float* cb, float (&o)[8]) {
    { const f32x4 b0 = *(const f32x4*)(cb + ch), b1 = *(const f32x4*)(cb + ch + 4);
#pragma unroll
      for (int j = 0; j < 4; ++j) { o[j] = b0[j]; o[4 + j] = b1[j]; } }
#pragma unroll
    for (int k = 0; k < 4; ++k) { const int tl = l - 3 + k;
        if (tbase + tl >= 0) { float v[8]; unpack8(*(const u32x4*)(proj + (row0 + tl) * PW + ch), v);
            const f32x4 w0 = *(const f32x4*)(cw + k * 1280 + ch), w1 = *(const f32x4*)(cw + k * 1280 + ch + 4);
#pragma unroll
            for (int j = 0; j < 4; ++j) { o[j] += w0[j] * v[j]; o[4 + j] += w1[j] * v[4 + j]; } } }
#pragma unroll
    for (int j = 0; j < 8; ++j) o[j] = silu_f(o[j]);
}
typedef float f32x2 __attribute__((ext_vector_type(2)));
__device__ __forceinline__ __amdgpu_buffer_rsrc_t seq_rsrc(const bf16_t* proj, long row0, int tbase) {
    return __builtin_amdgcn_make_buffer_rsrc((void*)(proj + (row0 - tbase) * PW), (short)0, (int)(SEQ * PW * 2), 0x00020000);
}
__device__ __forceinline__ void conv8_load(__amdgpu_buffer_rsrc_t rs, int tbase, int l, int ch, u32x4 (&raw)[4]) {
    const int voff = ((tbase + l - 3) * PW + ch) * 2;
#pragma unroll
    for (int k = 0; k < 4; ++k) raw[k] = __builtin_amdgcn_raw_buffer_load_b128(rs, voff + k * (PW * 2), 0, 0);
}
__device__ __forceinline__ void conv8_math(const u32x4 (&raw)[4], const float (&w)[4][8], const float (&bias)[8], float (&o)[8]);
__device__ __forceinline__ void conv8_w(__amdgpu_buffer_rsrc_t rs, int tbase, int l, int ch, const float (&w)[4][8], const float (&bias)[8], float (&o)[8]) {
    u32x4 raw[4]; conv8_load(rs, tbase, l, ch, raw); conv8_math(raw, w, bias, o);
}
__device__ __forceinline__ void conv8_math(const u32x4 (&raw)[4], const float (&w)[4][8], const float (&bias)[8], float (&o)[8]) {
    f32x2 a[4];
#pragma unroll
    for (int j = 0; j < 4; ++j) a[j] = (f32x2){bias[2 * j], bias[2 * j + 1]};
#pragma unroll
    for (int k = 0; k < 4; ++k) {
#pragma unroll
        for (int j = 0; j < 4; ++j) { const unsigned u = raw[k][j]; const f32x2 v = (f32x2){bflo(u), bfhi(u)}, wv = (f32x2){w[k][2 * j], w[k][2 * j + 1]}; a[j] = wv * v + a[j]; } }
#pragma unroll
    for (int j = 0; j < 4; ++j) { float sa, sb; sigmoid2(a[j].x, a[j].y, sa, sb); o[2 * j] = a[j].x * sa; o[2 * j + 1] = a[j].y * sb; }
}
__device__ __forceinline__ void load_conv_w(const float* cw, const float* cb, int ch, float (&w)[4][8], float (&bias)[8]) {
#pragma unroll
    for (int k = 0; k < 4; ++k) { const f32x4 a = *(const f32x4*)(cw + k * 1280 + ch), b = *(const f32x4*)(cw + k * 1280 + ch + 4);
#pragma unroll
        for (int j = 0; j < 4; ++j) { w[k][j] = a[j]; w[k][4 + j] = b[j]; } }
    const f32x4 a = *(const f32x4*)(cb + ch), b = *(const f32x4*)(cb + ch + 4);
#pragma unroll
    for (int j = 0; j < 4; ++j) { bias[j] = a[j]; bias[4 + j] = b[j]; }
}
template <int N>
__device__ __forceinline__ void conv_tok(const bf16_t* pch, long row0, int tbase, int lstart, const float (&w)[4], float bias, float* o) {
    float v[N + 3];
#pragma unroll
    for (int j = 0; j < N + 3; ++j) { const int tl = lstart - 3 + j; v[j] = (tbase + tl >= 0) ? bf2f(pch[(row0 + tl) * PW]) : 0.f; }
#pragma unroll
    for (int i = 0; i < N; ++i) o[i] = silu_f(bias + w[0] * v[i] + w[1] * v[i + 1] + w[2] * v[i + 2] + w[3] * v[i + 3]);
}
__device__ __forceinline__ void dt_cumsum(const float* dtb, long row0, int h, float bias, float A, int lane, float& d0, float& d1, float& cs0, float& cs1, float& tot) {
    d0 = softplus_f(dtb[(row0 + 2 * lane) * 16 + h] + bias); d1 = softplus_f(dtb[(row0 + 2 * lane + 1) * 16 + h] + bias);
    const float a1 = d1 * A; float v = d0 * A + a1;
#pragma unroll
    for (int d = 1; d < 64; d <<= 1) { const float t = __shfl_up(v, d); if (lane >= d) v += t; }
    tot = __shfl(v, 63); cs1 = v; cs0 = v - a1;
}

__device__ void phase_states(KP P, int layer, LAS unsigned char* lds) {
    const int tid = opaque_tid(), wid = tid >> 6, lane = tid & 63, r = lane & 15, q = lane >> 4;
    LAS bf16_t* BcT = (LAS bf16_t*)lds;
    LAS float* wgt = (LAS float*)(lds + 17408);
    LAS unsigned char* xsw = lds + 21504 + wid * 16384;
    const bf16_t* proj = (const bf16_t*)(P->ws + OFF_PROJ); const float* dtb = (const float*)(P->ws + OFF_DT);
    bf16_t* states = (bf16_t*)(P->ws + OFF_ST); float* totals = (float*)(P->ws + OFF_TOT);
    const float* cw = P->conv_w + layer * 4 * 1280; const float* cb = P->conv_b + layer * 1280;
    const int nblk = opaque_nblk();
    for (int item = blockIdx.x; item < 512; item += nblk) {
        const int g = item & 1, bc = item >> 1, b = bc >> 6, c = bc & 63, tbase = c * 128, h = g * 8 + wid;
        const long row0 = (long)b * SEQ + tbase;
        const __amdgpu_buffer_rsrc_t rsq = seq_rsrc(proj, row0, tbase);
        u32x4 rbb[2][4];
#pragma unroll
        for (int i = 0; i < 2; ++i) conv8_load(rsq, tbase, (tid >> 3) + 64 * i, 1024 + g * 64 + (tid & 7) * 8, rbb[i]);
        { float d0, d1, cs0, cs1, tot; dt_cumsum(dtb, row0, h, P->dt_bias[layer * 16 + h], -expf(P->a_log[layer * 16 + h]), lane, d0, d1, cs0, cs1, tot);
          { f32x2* dcs = (f32x2*)P->out; dcs[(row0 + 2 * lane) * 16 + h] = (f32x2){d0, cs0}; dcs[(row0 + 2 * lane + 1) * 16 + h] = (f32x2){d1, cs1}; }
          wgt[wid * 128 + 2 * lane] = d0 * __expf(tot - cs0); wgt[wid * 128 + 2 * lane + 1] = d1 * __expf(tot - cs1);
          if (lane == 0) totals[bc * 16 + h] = tot; }
        {
            float w[4][8], bias[8]; const int cgp = tid & 7; load_conv_w(cw, cb, 1024 + g * 64 + cgp * 8, w, bias);
#pragma unroll
            for (int i = 0; i < 2; ++i) { const int l = (tid >> 3) + 64 * i; float o[8]; conv8_math(rbb[i], w, bias, o);
#pragma unroll
                for (int e = 0; e < 8; e += 2) { const unsigned pk = cvt_pk_bf16(o[e], o[e + 1]);
                    BcT[(cgp * 8 + e) * 136 + (l ^ (cgp << 3))] = (bf16_t)pk; BcT[(cgp * 8 + e + 1) * 136 + (l ^ (cgp << 3))] = (bf16_t)(pk >> 16); } }
        }
        {
            float w[4][8], bias[8]; const int cgp = lane & 7; load_conv_w(cw, cb, h * 64 + cgp * 8, w, bias);
            asm volatile("s_waitcnt lgkmcnt(0)" ::: "memory");
            u32x4 rawb[2][4][4];
#pragma unroll
            for (int t = 0; t < 4; ++t) conv8_load(rsq, tbase, (lane >> 3) + 8 * t, h * 64 + cgp * 8, rawb[0][t]);
#pragma unroll
            for (int i = 0; i < 16; ++i) { const int l = (lane >> 3) + 8 * i; float o[8];
                if ((i & 3) == 0 && i < 12) {
#pragma unroll
                    for (int t = 0; t < 4; ++t) conv8_load(rsq, tbase, (lane >> 3) + 8 * (i + 4 + t), h * 64 + cgp * 8, rawb[((i >> 2) + 1) & 1][t]); }
                conv8_math(rawb[(i >> 2) & 1][i & 3], w, bias, o);
                if ((i & 3) == 3) asm volatile("" ::: "memory");
                const float wl = wgt[wid * 128 + l];
                LAS unsigned char* dst = xsw + ((cgp >> 1) * 4 + (l >> 5)) * 1024 + (((cgp & 1) * 8) + 16 * ((l & 31) >> 3)) * 16 + (l & 7) * 2;
#pragma unroll
                for (int e = 0; e < 8; e += 2) { const unsigned pk = cvt_pk_bf16(o[e] * wl, o[e + 1] * wl);
                    *(LAS bf16_t*)(dst + ((e ^ cgp) << 4)) = (bf16_t)pk; *(LAS bf16_t*)(dst + (((e + 1) ^ cgp) << 4)) = (bf16_t)(pk >> 16); } }
        }
        __syncthreads();
        f32x4 acc[4][4];
#pragma unroll
        for (int a = 0; a < 4; ++a)
#pragma unroll
            for (int n = 0; n < 4; ++n) acc[a][n] = (f32x4){0.f, 0.f, 0.f, 0.f};
#pragma unroll 1
        for (int ks = 0; ks < 4; ++ks) { const int lb = ks * 32 + q * 8;
            bf16x8 af[4], bfr[4];
#pragma unroll
            for (int pt = 0; pt < 4; ++pt) af[pt] = *(const LAS bf16x8*)(xsw + (pt * 4 + ks) * 1024 + ((lane ^ (2 * pt + (r >> 3))) << 4));
#pragma unroll
            for (int nt = 0; nt < 4; ++nt) bfr[nt] = *(const LAS bf16x8*)(BcT + (nt * 16 + r) * 136 + (lb ^ (((2 * nt + (r >> 3)) & 7) << 3)));
#pragma unroll
            for (int pt = 0; pt < 4; ++pt)
#pragma unroll
                for (int nt = 0; nt < 4; ++nt) acc[pt][nt] = __builtin_amdgcn_mfma_f32_16x16x32_bf16(bfr[nt], af[pt], acc[pt][nt], 0, 0, 0);
        }
        bf16_t* sp = states + (((size_t)bc * 16 + h) << 12);
#pragma unroll
        for (int pt = 0; pt < 4; ++pt)
#pragma unroll
            for (int nt = 0; nt < 4; ++nt)
                { u32x2 o; o.x = cvt_pk_bf16(acc[pt][nt][0], acc[pt][nt][1]); o.y = cvt_pk_bf16(acc[pt][nt][2], acc[pt][nt][3]); *(u32x2*)(sp + (pt * 16 + r) * 64 + nt * 16 + q * 4) = o; }
        __syncthreads();
    }
}

__device__ void phase_scan_sc(KP P, int layer) {
    const int tid = opaque_tid(); const int gtid = blockIdx.x * 512 + tid, gthreads = opaque_nblk() * 512;
    bf16_t* states = (bf16_t*)(P->ws + OFF_ST); const float* totals = (const float*)(P->ws + OFF_TOT);
    for (int e2 = gtid; e2 < 131072; e2 += gthreads) {
        const int b = e2 >> 15, rem = (e2 & 32767) * 2, h = rem >> 12;
        unsigned* p = (unsigned*)(states + (size_t)b * 64 * 65536 + rem);
        float r0 = 0.f, r1 = 0.f;
        for (int c0 = 0; c0 < 64; c0 += 16) { unsigned s[16]; float d[16];
#pragma unroll
            for (int i = 0; i < 16; ++i) { s[i] = p[(size_t)(c0 + i) * 32768]; d[i] = __expf(totals[(b * 64 + c0 + i) * 16 + h]); }
#pragma unroll
            for (int i = 0; i < 16; ++i) { p[(size_t)(c0 + i) * 32768] = cvt_pk_bf16(r0, r1); r0 = d[i] * r0 + bflo(s[i]); r1 = d[i] * r1 + bfhi(s[i]); } }
    }
    { float* ssq2 = (float*)(P->ws + OFF_SSQ2); for (int i = gtid; i < MTOK; i += gthreads) ssq2[i] = 0.f; }
    bf16_t* proj = (bf16_t*)(P->ws + OFF_PROJ); const float* w = P->sc_w + layer * 3 * 1024;
    for (int task = gtid; task < 2048 * 128; task += gthreads) {
        const int ch = (task & 127) * 8; const long rowS = (long)(task >> 7) * 16; const int tin = (int)(rowS & (SEQ - 1));
        float w0[8], w1[8], w2[8], hm2[8], hm1[8];
#pragma unroll
        for (int j = 0; j < 8; ++j) { w0[j] = w[ch + j]; w1[j] = w[1024 + ch + j]; w2[j] = w[2048 + ch + j]; hm2[j] = 0.f; hm1[j] = 0.f; }
        if (tin >= 2) { unpack8(*(const u32x4*)(proj + (rowS - 2) * PW + COL_HC + ch), hm2); unpack8(*(const u32x4*)(proj + (rowS - 1) * PW + COL_HC + ch), hm1); }
#pragma unroll
        for (int i = 0; i < 16; ++i) { float h0[8], bz[8]; bf16_t* bp = proj + (rowS + i) * PW + COL_BZ + ch;
            unpack8(*(const u32x4*)(proj + (rowS + i) * PW + COL_HC + ch), h0); unpack8(*(const u32x4*)bp, bz);
            float y[8];
#pragma unroll
            for (int j = 0; j < 8; ++j) { y[j] = bz[j] * (w0[j] * hm2[j] + w1[j] * hm1[j] + w2[j] * h0[j]); hm2[j] = hm1[j]; hm1[j] = h0[j]; }
            *(u32x4*)bp = __builtin_bit_cast(u32x4, pack8(y)); }
    }
}

__device__ void phase_ssd_out(KP P, int layer, LAS unsigned char* lds) {
    const int tid = opaque_tid(), wid = tid >> 6, lane = tid & 63, r = lane & 15, q = lane >> 4;
    LAS bf16_t* Bc = (LAS bf16_t*)lds;
    LAS bf16_t* Cc = (LAS bf16_t*)(lds + 18432);
    LAS float* csA = (LAS float*)(lds + 36864);
    LAS float* dtA = (LAS float*)(lds + 40960);
    LAS float* red = (LAS float*)(lds + 45056);
    LAS unsigned char* xdL = lds + 49152;
    LAS float* fsA = (LAS float*)(lds + 114688);
    bf16_t* proj = (bf16_t*)(P->ws + OFF_PROJ); const float* dtb = (const float*)(P->ws + OFF_DT);
    const bf16_t* states = (const bf16_t*)(P->ws + OFF_ST);
    const float* cw = P->conv_w + layer * 4 * 1280; const float* cb = P->conv_b + layer * 1280;
    const int nblk = opaque_nblk();
    for (int item = blockIdx.x; item < 512; item += nblk) {
        const int g = item & 1, bc = item >> 1, b = bc >> 6, c = bc & 63, tbase = c * 128, h = g * 8 + wid;
        const long row0 = (long)b * SEQ + tbase;
        const __amdgpu_buffer_rsrc_t rsq = seq_rsrc(proj, row0, tbase);
        u32x4 rbc[4][4];
        { const int cg16 = tid & 15, chbc = 1024 + ((cg16 >> 3) * 128) + g * 64 + (cg16 & 7) * 8;
#pragma unroll
          for (int i = 0; i < 4; ++i) conv8_load(rsq, tbase, (tid >> 4) + 32 * i, chbc, rbc[i]); }
        { const f32x2* dcs = (const f32x2*)P->out; const f32x2 t0 = dcs[(row0 + 2 * lane) * 16 + h], t1 = dcs[(row0 + 2 * lane + 1) * 16 + h];
          const float d0 = t0.x, cs0 = t0.y, d1 = t1.x, cs1 = t1.y;
          csA[wid * 128 + 2 * lane] = cs0; csA[wid * 128 + 2 * lane + 1] = cs1; dtA[wid * 128 + 2 * lane] = d0; dtA[wid * 128 + 2 * lane + 1] = d1;
          const float ce = __shfl(cs1, (lane & 48) | 15);
          fsA[wid * 128 + 2 * lane] = __expf(ce - cs0); fsA[wid * 128 + 2 * lane + 1] = __expf(ce - cs1); }
        {
            float w[4][8], bias[8]; const int cgp = tid & 15, ch = 1024 + ((cgp >> 3) * 128) + g * 64 + (cgp & 7) * 8; load_conv_w(cw, cb, ch, w, bias);
            LAS bf16_t* dstb = ((cgp >> 3) ? Cc : Bc) + (cgp & 7) * 8;
#pragma unroll
            for (int i = 0; i < 4; ++i) { const int l = (tid >> 4) + 32 * i; float o[8]; conv8_math(rbc[i], w, bias, o);
                *(LAS u32x4*)(dstb + l * 72) = __builtin_bit_cast(u32x4, pack8(o)); }
        }
        __syncthreads();
        const float Dh = P->d_skip[layer * 16 + h];
        const LAS float* csw = csA + wid * 128; const LAS float* dtw = dtA + wid * 128; const LAS float* fsw = fsA + wid * 128;
        const bf16_t* stp = states + (((size_t)bc * 16 + h) << 12);
        bf16_t* zbase = proj + row0 * PW + COL_Z + h * 64;
        LAS unsigned char* xdw = xdL + wid * 8192;
        const int xsl = (lane ^ ((r >> 3) + 2 * q)) << 4;
#pragma unroll 1
        for (int ph = 0; ph < 2; ++ph) {
            {
                float w[4][8], bias[8]; const int cgp = lane & 3, ch = h * 64 + ph * 32 + cgp * 8; load_conv_w(cw, cb, ch, w, bias);
                u32x4 rawb[2][4][4];
#pragma unroll
                for (int t4 = 0; t4 < 4; ++t4) conv8_load(rsq, tbase, (lane >> 2) + 16 * t4, ch, rawb[0][t4]);
#pragma unroll
                for (int i = 0; i < 8; ++i) { const int l = (lane >> 2) + 16 * i; float o[8];
                    if (i == 0) {
#pragma unroll
                        for (int t4 = 0; t4 < 4; ++t4) conv8_load(rsq, tbase, (lane >> 2) + 16 * (4 + t4), ch, rawb[1][t4]); }
                    conv8_math(rawb[i >> 2][i & 3], w, bias, o);
                    if (i == 3) asm volatile("" ::: "memory");
                    const float dl = dtw[l]; const int t = l & 31;
                    LAS unsigned char* dst = xdw + ((l >> 5) * 2 + (cgp >> 1)) * 1024 + (((cgp & 1) * 8) + 16 * ((t & 15) >> 2)) * 16 + ((t & 3) + 4 * (t >> 4)) * 2;
                    const int swz = (cgp & 1) + 2 * ((t & 15) >> 2);
#pragma unroll
                    for (int e = 0; e < 8; e += 2) { const unsigned pk = cvt_pk_bf16(o[e] * dl, o[e + 1] * dl);
                        *(LAS bf16_t*)(dst + ((e ^ swz) << 4)) = (bf16_t)pk; *(LAS bf16_t*)(dst + (((e + 1) ^ swz) << 4)) = (bf16_t)(pk >> 16); } }
            }
            LAS unsigned char* bpw = lds + 118784 + wid * 4096 + lane * 16;
#pragma unroll
            for (int pt2 = 0; pt2 < 2; ++pt2)
#pragma unroll
                for (int ks = 0; ks < 2; ++ks) *(LAS bf16x8*)(bpw + (pt2 * 2 + ks) * 1024) = *(const bf16x8*)(stp + ((2 * ph + pt2) * 16 + r) * 64 + ks * 32 + q * 8);
            bf16_t* zl = zbase + (long)r * PW + ph * 32 + q * 4;
#pragma unroll 1
            for (int ltp = 0; ltp < 4; ++ltp) {
                u32x2 zv[2][2]; bf16x8 cf[2][2]; f32x4 acc[2][2]; float csl[2], dsk[2]; int lrow[2];
#pragma unroll
                for (int u = 0; u < 2; ++u) { const int lt = 2 * ltp + u, l = lt * 16 + r; lrow[u] = l;
                    zv[u][0] = *(const u32x2*)(zl + (long)lt * 16 * PW); zv[u][1] = *(const u32x2*)(zl + (long)lt * 16 * PW + 16);
                    cf[u][0] = *(const LAS bf16x8*)(Cc + l * 72 + q * 8); cf[u][1] = *(const LAS bf16x8*)(Cc + l * 72 + 32 + q * 8);
                    csl[u] = csw[l]; dsk[u] = Dh * __builtin_amdgcn_rcpf(dtw[l]); }
#pragma unroll
                for (int u = 0; u < 2; ++u)
#pragma unroll
                    for (int pt2 = 0; pt2 < 2; ++pt2) { f32x4 a = (f32x4){0.f, 0.f, 0.f, 0.f};
                        a = __builtin_amdgcn_mfma_f32_16x16x32_bf16(*(const LAS bf16x8*)(bpw + (pt2 * 2) * 1024), cf[u][0], a, 0, 0, 0); a = __builtin_amdgcn_mfma_f32_16x16x32_bf16(*(const LAS bf16x8*)(bpw + (pt2 * 2 + 1) * 1024), cf[u][1], a, 0, 0, 0);
                        acc[u][pt2] = a * __expf(csl[u]); }
#pragma unroll 2
                for (int sp = 0; sp <= ltp; ++sp) { const int sA = sp * 32 + q * 4, sB = sA + 16;
                    const f32x4 csa = *(const LAS f32x4*)(csw + sA), csb = *(const LAS f32x4*)(csw + sB);
                    const LAS bf16_t* bq = Bc + (sp * 32 + r) * 72 + q * 8;
                    const bf16x8 a00 = *(const LAS bf16x8*)bq, a01 = *(const LAS bf16x8*)(bq + 32), a10 = *(const LAS bf16x8*)(bq + 16 * 72), a11 = *(const LAS bf16x8*)(bq + 16 * 72 + 32);
                    const bf16x8 bx0 = *(const LAS bf16x8*)(xdw + (sp * 2) * 1024 + xsl), bx1 = *(const LAS bf16x8*)(xdw + (sp * 2 + 1) * 1024 + xsl);
                    f32x4 g[2][2];
#pragma unroll
                    for (int u = 0; u < 2; ++u) { f32x4 g0 = (f32x4){0.f, 0.f, 0.f, 0.f}, g1 = (f32x4){0.f, 0.f, 0.f, 0.f};
                        g0 = __builtin_amdgcn_mfma_f32_16x16x32_bf16(a00, cf[u][0], g0, 0, 0, 0); g0 = __builtin_amdgcn_mfma_f32_16x16x32_bf16(a01, cf[u][1], g0, 0, 0, 0);
                        g1 = __builtin_amdgcn_mfma_f32_16x16x32_bf16(a10, cf[u][0], g1, 0, 0, 0); g1 = __builtin_amdgcn_mfma_f32_16x16x32_bf16(a11, cf[u][1], g1, 0, 0, 0);
                        g[u][0] = g0; g[u][1] = g1; }
#pragma unroll
                    for (int u = 0; u < 2; ++u) { float mv[8]; const int l = lrow[u];
                        if (sp == ltp) {
#pragma unroll
                            for (int j = 0; j < 4; ++j) { const int s0 = sA + j, s1 = sB + j;
                                if (u == 0) { float m0 = (s0 <= l) ? g[u][0][j] * __expf(csl[u] - csa[j]) : 0.f; if (s0 == l) m0 += dsk[u]; mv[j] = m0; mv[4 + j] = 0.f; }
                                else { mv[j] = g[u][0][j] * __expf(csl[u] - csa[j]);
                                       float m1 = (s1 <= l) ? g[u][1][j] * __expf(csl[u] - csb[j]) : 0.f; if (s1 == l) m1 += dsk[u]; mv[4 + j] = m1; } }
                        } else {
                            const float el = __expf(csl[u] - csw[sp * 32 + 31]);
                            const f32x4 fa = *(const LAS f32x4*)(fsw + sA) * el, fb = *(const LAS f32x4*)(fsw + sB) * el;
#pragma unroll
                            for (int j = 0; j < 4; ++j) { mv[j] = g[u][0][j] * fa[j]; mv[4 + j] = g[u][1][j] * fb[j]; }
                        }
                        const bf16x8 mf = pack8(mv);
                        acc[u][0] = __builtin_amdgcn_mfma_f32_16x16x32_bf16(bx0, mf, acc[u][0], 0, 0, 0);
                        acc[u][1] = __builtin_amdgcn_mfma_f32_16x16x32_bf16(bx1, mf, acc[u][1], 0, 0, 0); }
                }
#pragma unroll
                for (int u = 0; u < 2; ++u) { const int lt = 2 * ltp + u; const f32x4 acc0 = acc[u][0], acc1 = acc[u][1]; const u32x2 z0 = zv[u][0], z1 = zv[u][1];
                  float s0, s1, s2, s3, s4, s5, s6, s7;
                  sigmoid2(bflo(z0.x), bfhi(z0.x), s0, s1); sigmoid2(bflo(z0.y), bfhi(z0.y), s2, s3); sigmoid2(bflo(z1.x), bfhi(z1.x), s4, s5); sigmoid2(bflo(z1.y), bfhi(z1.y), s6, s7);
                  const float y0 = acc0[0] * bflo(z0.x) * s0, y1 = acc0[1] * bfhi(z0.x) * s1, y2 = acc0[2] * bflo(z0.y) * s2, y3 = acc0[3] * bfhi(z0.y) * s3;
                  const float y4 = acc1[0] * bflo(z1.x) * s4, y5 = acc1[1] * bfhi(z1.x) * s5, y6 = acc1[2] * bflo(z1.y) * s6, y7 = acc1[3] * bfhi(z1.y) * s7;
                  bf16_t* zp = zl + (long)lt * 16 * PW;
                  u32x2 o0, o1; o0.x = cvt_pk_bf16(y0, y1); o0.y = cvt_pk_bf16(y2, y3); o1.x = cvt_pk_bf16(y4, y5); o1.y = cvt_pk_bf16(y6, y7);
                  *(u32x2*)zp = o0; *(u32x2*)(zp + 16) = o1;
                  float sq = (y0 * y0 + y1 * y1) + (y2 * y2 + y3 * y3) + (y4 * y4 + y5 * y5) + (y6 * y6 + y7 * y7);
                  sq += __shfl_xor(sq, 16); sq += __shfl_xor(sq, 32);
                  if (q == 0) { LAS float* rp = red + wid * 128 + lrow[u]; *rp = (ph == 0) ? sq : (*rp + sq); } }
            }
        }
        __syncthreads();
        {
            const float* nw = P->ssd_norm + layer * 1024 + h * 64; f32x4 nwv[4];
#pragma unroll
            for (int pt = 0; pt < 4; ++pt) nwv[pt] = *(const f32x4*)(nw + pt * 16 + q * 4);
#pragma unroll
            for (int lt = 0; lt < 8; ++lt) { const int l = lt * 16 + r; float t = 0.f;
#pragma unroll
                for (int w = 0; w < 8; ++w) t += red[w * 128 + l];
                const float rstd = rsqrtf(t * (1.f / 512.f) + EPS);
                bf16_t* zp = zbase + (long)l * PW + q * 4; u32x2 v[4];
#pragma unroll
                for (int pt = 0; pt < 4; ++pt) v[pt] = *(const u32x2*)(zp + pt * 16);
#pragma unroll
                for (int pt = 0; pt < 4; ++pt) { u32x2 o; o.x = cvt_pk_bf16(bflo(v[pt].x) * rstd * nwv[pt][0], bfhi(v[pt].x) * rstd * nwv[pt][1]);
                    o.y = cvt_pk_bf16(bflo(v[pt].y) * rstd * nwv[pt][2], bfhi(v[pt].y) * rstd * nwv[pt][3]); *(u32x2*)(zp + pt * 16) = o; }
                }
        }
    }
}

__device__ void phase_x1(KP P, int layer) {
    const int tid = opaque_tid(), lane = tid & 63; const int gw = blockIdx.x * 8 + (tid >> 6), nw = opaque_nblk() * 8;
    const bf16_t* xin = (const bf16_t*)(P->ws + OFF_XB); const bf16_t* mix = (const bf16_t*)P->out; const float* ssq2 = (const float*)(P->ws + OFF_SSQ2);
    float* ssq = (float*)(P->ws + OFF_SSQ);
    bf16_t* x1b = (bf16_t*)(P->ws + OFF_PROJ); const float* nwp = P->norm_post + layer * 1024;
    f32x4 wv[2][2];
#pragma unroll
    for (int i = 0; i < 2; ++i) { wv[i][0] = *(const f32x4*)(nwp + lane * 8 + 512 * i); wv[i][1] = *(const f32x4*)(nwp + lane * 8 + 512 * i + 4); }
#pragma unroll 8
    for (int row = gw; row < MTOK; row += nw) {
        const float rstd = rsqrtf(ssq2[row] * (1.f / 1024.f) + EPS);
        if (lane == 0) ssq[row] = 0.f;
#pragma unroll
        for (int i = 0; i < 2; ++i) { const size_t off = (size_t)row * 1024 + lane * 8 + 512 * i;
            float xv[8], mv[8]; unpack8(*(const u32x4*)(xin + off), xv); unpack8(*(const u32x4*)(mix + off), mv);
#pragma unroll
            for (int j = 0; j < 4; ++j) { xv[j] += mv[j] * rstd * wv[i][0][j]; xv[4 + j] += mv[4 + j] * rstd * wv[i][1][j]; }
            *(u32x4*)(x1b + off) = __builtin_bit_cast(u32x4, pack8(xv)); }
    }
}

#define XB_TMO      128
#define XB_XCNT(j)  (256  + 64 * (j))
#define XB_XSUB(j)  (1280 + 64 * (j))
#define XB_XGEN(j)  (2304 + 64 * (j))
#define XB_TOP      3328
#define XB_TOPGEN   3392
#define XCD_BAR_WORDS 3456
#define XB_SPIN_CAP (1u << 18)
__device__ __forceinline__ unsigned xb_ld(unsigned* p)              { return __hip_atomic_load(p, __ATOMIC_RELAXED, __HIP_MEMORY_SCOPE_AGENT); }
__device__ __forceinline__ unsigned xb_add(unsigned* p, unsigned v) { return __hip_atomic_fetch_add(p, v, __ATOMIC_RELAXED, __HIP_MEMORY_SCOPE_AGENT); }
__device__ __forceinline__ unsigned xb_xcc_id() { return (unsigned)__builtin_amdgcn_s_getreg((3 << 11) | 20) & 0xFu; }
#define XB_SPIN(cond, bar) do { unsigned _sp = 0; while (cond) { __builtin_amdgcn_s_sleep(1); \
    if ((++_sp & 255u) == 0u) { if (xb_ld(&(bar)[XB_TMO])) break; if (_sp > XB_SPIN_CAP) { atomicAdd(&(bar)[XB_TMO], 1u); break; } } } } while (0)
struct XcdBarrier { unsigned* bar; unsigned x; volatile LAS unsigned* st; };
__device__ __forceinline__ XcdBarrier xcd_barrier_post(unsigned* bar, volatile LAS unsigned* st) {
    XcdBarrier b; b.bar = bar; b.x = xb_xcc_id(); b.st = st;
    if (threadIdx.x == 0) (void)xb_add(&bar[XB_XCNT(b.x)], 1u);
    return b;
}
__device__ __forceinline__ void xcd_barrier_complete(unsigned* bar, unsigned x, unsigned& nloc, unsigned& nx) {
    const unsigned G = gridDim.x * gridDim.y * gridDim.z;
    unsigned sum, cnt, mine, sp = 0u;
    for (;;) {
        sum = 0u; cnt = 0u; mine = 0u;
#pragma unroll
        for (unsigned j = 0; j < 16; ++j) { const unsigned c = xb_ld(&bar[XB_XCNT(j)]); sum += c; cnt += (c > 0u) ? 1u : 0u; mine = (j == x) ? c : mine; }
        if (sum == G) break;
        __builtin_amdgcn_s_sleep(1);
        if ((++sp & 255u) == 0u) { if (xb_ld(&bar[XB_TMO])) break; if (sp > XB_SPIN_CAP) { atomicAdd(&bar[XB_TMO], 1u); break; } }
    }
    nloc = mine > 0u ? mine : 1u; nx = cnt > 0u ? cnt : 1u;
}
__device__ __forceinline__ void xcd_barrier(const XcdBarrier& b) {
    asm volatile("s_waitcnt vmcnt(0)" ::: "memory");
    __syncthreads();
    if (threadIdx.x == 0) {
        unsigned* bar = b.bar; asm volatile("" : "+s"(bar));
        __builtin_amdgcn_s_waitcnt(0);
        unsigned nloc = b.st[0], nx = b.st[1];
        if (nloc == 0u) { xcd_barrier_complete(bar, b.x, nloc, nx); b.st[0] = nloc; b.st[1] = nx; }
        const unsigned old = xb_add(&bar[XB_XSUB(b.x)], 1u);
        const unsigned gen = old / nloc;
        if (old + 1u == (gen + 1u) * nloc) {
            __builtin_amdgcn_fence(__ATOMIC_RELEASE, "agent");
            asm volatile("s_waitcnt vmcnt(0)" ::: "memory");
            const unsigned og = xb_add(&bar[XB_TOP], 1u);
            const unsigned tg = og / nx;
            if (og + 1u == (tg + 1u) * nx) xb_add(&bar[XB_TOPGEN], 1u);
            else XB_SPIN(xb_ld(&bar[XB_TOPGEN]) == tg, bar);
            __builtin_amdgcn_fence(__ATOMIC_ACQUIRE, "agent");
            xb_add(&bar[XB_XGEN(b.x)], 1u);
            asm volatile("s_waitcnt vmcnt(0)" ::: "memory");
        } else {
            XB_SPIN(xb_ld(&bar[XB_XGEN(b.x)]) == gen, bar);
            __builtin_amdgcn_fence(__ATOMIC_ACQUIRE, "agent");
            asm volatile("s_waitcnt vmcnt(0)" ::: "memory");
        }
    }
    __syncthreads();
}

__global__ void __launch_bounds__(512, 2) fwd_megakernel(Params Pval) {
    (void)Pval;
    extern __shared__ __attribute__((aligned(16))) unsigned char shm[];
    LAS unsigned char* lds = (LAS unsigned char*)shm;
    cg::grid_group grid = cg::this_grid();
    pg8::StaticOrder S;
    const int ph_lo = kernarg_params()->ph_lo, ph_hi = kernarg_params()->ph_hi;
    unsigned char* ws0 = kernarg_params()->ws;
    volatile LAS unsigned* stw = (volatile LAS unsigned*)(lds + LDS_BYTES - 16);
    if (threadIdx.x == 0) { stw[0] = 0u; stw[1] = 0u; }
    __syncthreads();
    const XcdBarrier xbar = xcd_barrier_post((unsigned*)(ws0 + OFF_BAR), stw);
    int rep = 0; (void)rep;
    for (int ph = ph_lo; ph < ph_hi; ++ph) {
        const KP P = kernarg_params(); unsigned char* ws = P->ws;
        if (ph == 0) phase_prologue(P, lds);
        else {
            const int layer = (ph - 1) / 7, sub = (ph - 1) % 7;
            if (sub == 0 || sub == 4 || sub == 6) {
                const int ngi = (sub == 0) ? 2 : 1;
                for (int gi = 0; gi < ngi; ++gi) {
                    pg8::Gemm g; EpiAll E{0, layer, ws, P->out};
                    if (sub == 0 && gi == 0) {
                        g = pg8::Gemm{(const bf16_t*)(ws + OFF_XB), (const bf16_t*)(ws + OFF_BTIN) + (size_t)layer * NIN * 1024, MTOK, NIN, 1024, 1024};
                        E.mode = 0;
                    } else if (sub == 0) {
                        g = pg8::Gemm{(const bf16_t*)(ws + OFF_PB) + (size_t)layer * MTOK * 256, (const bf16_t*)(ws + OFF_BTP) + (size_t)layer * 1024 * 256, MTOK, 1024, 256, 256};
                        E.mode = 1;
                    } else if (sub == 4) {
                        g = pg8::Gemm{(const bf16_t*)(ws + OFF_PROJ) + COL_Z, (const bf16_t*)(ws + OFF_BTOUT) + (size_t)layer * 1024 * 2048, MTOK, 1024, 2048, PW};
                        E.mode = 2;
                    } else {
                        g = pg8::Gemm{(const bf16_t*)(ws + OFF_PROJ), (const bf16_t*)(ws + OFF_BTG) + (size_t)layer * 1024 * 1024, MTOK, 1024, 1024, 1024};
                        E.mode = 3;
                    }
                    S.init(g.M, g.N, opaque_nblk(), blockIdx.x); pg8::gemm_phase(lds, g, S, E);
                }
            } else if (sub == 1) phase_states(P, layer, lds);
            else if (sub == 2) phase_scan_sc(P, layer);
            else if (sub == 3) phase_ssd_out(P, layer, lds);
            else phase_x1(P, layer);
        }
        if (ph + 1 < ph_hi) { if (ph_lo != 0) grid.sync(); else xcd_barrier(xbar); }
#ifdef DBL_SUB
        if (ph > 0 && (ph - 1) % 7 == DBL_SUB && !rep) { rep = 1; --ph; } else rep = 0;
#endif
    }
}

extern "C" void kernel_launch(void* const* d_in, const int* in_sizes, int n_in, void* d_out, int out_size, void* d_ws, size_t ws_size, hipStream_t stream) {
    static int grid_blocks = 0;
    if (grid_blocks == 0) {
        if (n_in != 15 || ws_size < WS_END) { fprintf(stderr, "kernel_launch: need 15 inputs and %zu bytes of workspace (got %d, %zu)\n", (size_t)WS_END, n_in, ws_size); grid_blocks = -1; return; }
        int dev = 0, cus = 0, per_cu = 0;
        hipGetDevice(&dev); hipDeviceGetAttribute(&cus, hipDeviceAttributeMultiprocessorCount, dev);
        if (hipFuncSetAttribute((const void*)fwd_megakernel, hipFuncAttributeMaxDynamicSharedMemorySize, LDS_BYTES) != hipSuccess) { fprintf(stderr, "kernel_launch: hipFuncSetAttribute failed\n"); grid_blocks = -1; return; }
        if (hipOccupancyMaxActiveBlocksPerMultiprocessor(&per_cu, (const void*)fwd_megakernel, 512, LDS_BYTES) != hipSuccess || per_cu < 1) per_cu = 1;
        (void)hipGetLastError();
        grid_blocks = cus * 1;
        if (grid_blocks <= 0) grid_blocks = 256;
    }
    if (grid_blocks < 0) return;
    Params P{};
    P.x = (const float*)d_in[0]; P.p = (const float*)d_in[1]; P.norm_pre = (const float*)d_in[2]; P.norm_post = (const float*)d_in[3]; P.w_in = (const float*)d_in[4];
    P.conv_w = (const float*)d_in[5]; P.conv_b = (const float*)d_in[6]; P.dt_bias = (const float*)d_in[7]; P.a_log = (const float*)d_in[8]; P.d_skip = (const float*)d_in[9];
    P.ssd_norm = (const float*)d_in[10]; P.sc_w = (const float*)d_in[11]; P.w_out = (const float*)d_in[12]; P.w_g = (const float*)d_in[13]; P.w_p = (const float*)d_in[14];
    P.out = (float*)d_out; P.ws = (unsigned char*)d_ws;
    (void)hipMemsetAsync((unsigned char*)d_ws + OFF_BAR, 0, XCD_BAR_WORDS * 4, stream);
    P.ph_lo = 0; P.ph_hi = 15;
    void* args[] = {&P};
    hipError_t e = hipLaunchCooperativeKernel((const void*)fwd_megakernel, dim3(grid_blocks), dim3(512), args, LDS_BYTES, stream);
    if (e != hipSuccess) fprintf(stderr, "cooperative launch failed: %s (grid %d)\n", hipGetErrorString(e), grid_blocks);
}
```

```cpp
#include <hip/hip_runtime.h>
#include <hip/hip_cooperative_groups.h>
#include <cstdio>
namespace cg = cooperative_groups;

#define LAS __attribute__((address_space(3)))
typedef unsigned short bf16_t;
typedef short bf16x8 __attribute__((ext_vector_type(8)));
typedef float f32x4 __attribute__((ext_vector_type(4)));
typedef unsigned u32x4 __attribute__((ext_vector_type(4)));
typedef unsigned u32x2 __attribute__((ext_vector_type(2)));

constexpr int MTOK = 32768, DM = 1024, SEQ = 8192, NCH = 64  , PW = 4352  ;
constexpr int NIN = 6656;
constexpr float EPS = 1e-6f;
constexpr int COL_Z = 1280, COL_BZ = 2304, COL_HC = 3328;

constexpr size_t SZ_BTIN = (size_t)2 * NIN * 1024 * 2, SZ_BTOUT = (size_t)2 * 1024 * 2048 * 2, SZ_BTG = (size_t)2 * 1024 * 1024 * 2, SZ_BTP = (size_t)2 * 1024 * 256 * 2;
constexpr size_t OFF_BTIN = 0, OFF_BTOUT = OFF_BTIN + SZ_BTIN, OFF_BTG = OFF_BTOUT + SZ_BTOUT, OFF_BTP = OFF_BTG + SZ_BTG;
constexpr size_t OFF_PB = OFF_BTP + SZ_BTP, SZ_PB = (size_t)2 * MTOK * 256 * 2;
constexpr size_t OFF_XB = OFF_PB + SZ_PB, SZ_XB = (size_t)MTOK * 1024 * 2;
constexpr size_t OFF_SSQ = OFF_XB + SZ_XB, SZ_SSQ = (size_t)MTOK * 16 * 4;
constexpr size_t OFF_SSQ2 = OFF_SSQ + SZ_SSQ;
constexpr size_t OFF_DT = OFF_SSQ2 + SZ_SSQ;
constexpr size_t OFF_TOT = OFF_DT + SZ_SSQ, SZ_TOT = 4 * 64 * 16 * 4;
constexpr size_t OFF_BAR = OFF_TOT + SZ_TOT, SZ_BAR = 16384;
constexpr size_t OFF_PROJ = OFF_BAR + SZ_BAR, SZ_PROJ = (size_t)MTOK * PW * 2;
constexpr size_t OFF_PP = OFF_PROJ + SZ_PROJ, SZ_PP = (size_t)MTOK * 1024 * 2;
constexpr size_t OFF_ST = OFF_PP + SZ_PP, SZ_ST = (size_t)4 * 64 * 16 * 4096 * 2;
constexpr size_t WS_END = OFF_ST + SZ_ST;

constexpr int LDS_BYTES = 152576 + 16;

struct Params {
    const float* x; const float* p; const float* norm_pre; const float* norm_post; const float* w_in; const float* conv_w; const float* conv_b;
    const float* dt_bias; const float* a_log; const float* d_skip; const float* ssd_norm; const float* sc_w; const float* w_out; const float* w_g; const float* w_p;
    float* out; unsigned char* ws; int ph_lo, ph_hi;
};

typedef const __attribute__((address_space(4))) Params* KP;
__device__ __forceinline__ KP kernarg_params() { KP p = (KP)__builtin_amdgcn_kernarg_segment_ptr(); asm volatile("" : "+s"(p)); return p; }
__device__ __forceinline__ int opaque_nblk() { int g = (int)gridDim.x; asm volatile("" : "+s"(g)); return g; }
__device__ __forceinline__ int opaque_tid() { int t = threadIdx.x; asm volatile("" : "+v"(t)); return t; }
__device__ __forceinline__ unsigned cvt_pk_bf16(float lo, float hi) { unsigned r; asm volatile("v_cvt_pk_bf16_f32 %0, %1, %2" : "=v"(r) : "v"(lo), "v"(hi)); return r; }
__device__ __forceinline__ bf16_t f2bf(float f) { return (bf16_t)(cvt_pk_bf16(f, 0.f) & 0xffffu); }
__device__ __forceinline__ float bf2f(bf16_t b) { return __uint_as_float(((unsigned)b) << 16); }
__device__ __forceinline__ float bflo(unsigned w) { return __uint_as_float(w << 16); }
__device__ __forceinline__ float bfhi(unsigned w) { return __uint_as_float(w & 0xffff0000u); }
__device__ __forceinline__ float silu_f(float v) { return v * __builtin_amdgcn_rcpf(1.f + __expf(-v)); }
__device__ __forceinline__ float sigmoid_f(float v) { return __builtin_amdgcn_rcpf(1.f + __expf(-v)); }
__device__ __forceinline__ void sigmoid2(float a, float b, float& sa, float& sb) {
    const float ea = 1.f + __expf(fminf(-a, 40.f)), eb = 1.f + __expf(fminf(-b, 40.f)); const float r = __builtin_amdgcn_rcpf(ea * eb); sa = r * eb; sb = r * ea; }
__device__ __forceinline__ float softplus_f(float v) { return v > 20.f ? v : log1pf(__expf(v)); }
__device__ __forceinline__ bf16x8 pack8(const float (&v)[8]) {
    u32x4 w; w.x = cvt_pk_bf16(v[0], v[1]); w.y = cvt_pk_bf16(v[2], v[3]); w.z = cvt_pk_bf16(v[4], v[5]); w.w = cvt_pk_bf16(v[6], v[7]);
    return __builtin_bit_cast(bf16x8, w);
}
__device__ __forceinline__ void unpack8(u32x4 w, float (&v)[8]) {
    v[0] = bflo(w.x); v[1] = bfhi(w.x); v[2] = bflo(w.y); v[3] = bfhi(w.y); v[4] = bflo(w.z); v[5] = bfhi(w.z); v[6] = bflo(w.w); v[7] = bfhi(w.w);
}

namespace pg8 {
constexpr int BM = 256, BK = 64, HALF = 128, HTB = HALF * BK * 2, STAGE_BYTES = 8 * HTB, NXCD = 8, WGM = 8;
__host__ __device__ __forceinline__ int lds_byte(int r, int c) { const int st = (r >> 4) * 2 + (c >> 5), rr = r & 15, cc = c & 31, ob = rr * 64 + cc * 2; return st * 1024 + (ob ^ (((ob >> 9) & 1) << 5)); }
__host__ __device__ __forceinline__ void stage_rc(int b, int& R, int& C) { const int st = b / 1024, sb = b % 1024, swz = sb ^ (((sb >> 9) & 1) << 5); R = (st >> 1) * 16 + swz / 64; C = (st & 1) * 32 + (swz % 64) / 2; }
__host__ __device__ __forceinline__ int perm32(int rho) { const int n = rho >> 4, i = rho & 15; return 8 * (i >> 2) + 4 * n + (i & 3); }
struct Unit { int pm, pn; };
struct Gemm { const bf16_t* A; const bf16_t* Bt; int M, N, K, lda; };
struct StaticOrder {
    int nM, nN, nwg, G, c;
    __device__ void init(int M, int N, int G_, int c_) { nM = M / BM; nN = N / BM; nwg = nM * nN; G = G_; c = c_; }
    __device__ bool next(int i, Unit& u) const {
        const long L = (long)i * G + c; if (L >= nwg) return false;
        int wgid = (int)L; { const int q = nwg / NXCD, r = nwg % NXCD, xcd = wgid % NXCD, off = wgid / NXCD; wgid = (xcd < r ? xcd * (q + 1) : r * (q + 1) + (xcd - r) * q) + off; }
        const int nig = WGM * nN, gid = wgid / nig, fm = gid * WGM, gsz = (nM - fm) < WGM ? (nM - fm) : WGM;
        u.pm = fm + ((wgid % nig) % gsz); u.pn = (wgid % nig) / gsz; return true;
    }
};

template <class Epi>
__device__ __forceinline__ void gemm_phase(LAS unsigned char* lds, const Gemm g, const StaticOrder& S, const Epi& E) {
    const int tid = opaque_tid(), wid = __builtin_amdgcn_readfirstlane(tid >> 6), lane = tid & 63, wr = wid >> 2, wc = wid & 3, fr = lane & 15, fq = lane >> 4;
    const int K = g.K, nt = K / BK, lda = g.lda;
    unsigned voffA[2], voffB[2];
#pragma unroll
    for (int i = 0; i < 2; ++i) { int R, C; stage_rc(tid * 16 + i * 8192, R, C); const int Rb = Epi::PERM ? ((R & ~31) + perm32(R & 31)) : R;
        voffA[i] = (unsigned)(R * lda + C) * 2u; voffB[i] = (unsigned)(Rb * K + C) * 2u; }
    const size_t kstep = (size_t)(BK * 2);
    const size_t hstepA = (size_t)HALF * lda * 2, hstepB = (size_t)HALF * K * 2;
    const size_t tstepA = 2 * hstepA, tstepB = 2 * hstepB;
    const unsigned ldsw = (unsigned)wid * 1024u;
    const int aoff = lds_byte(wr * 64 + fr, fq * 8), boff = lds_byte(wc * 32 + fr, fq * 8);
#define PG8_SA(b, h) (((b) * 2 + (h)) * HTB)
#define PG8_SB(b, h) ((4 + (b) * 2 + (h)) * HTB)
#define PG8_STAGE(bufoff, gbase, voff) do { _Pragma("unroll") for (int _i = 0; _i < 2; ++_i) \
        __builtin_amdgcn_global_load_lds((const unsigned*)((const char*)(gbase) + (voff)[_i]), (LAS unsigned*)(lds + (bufoff) + ldsw + _i * 8192), 16, 0, 0); } while (0)
#define PG8_LDA(dst, b, h) do { _Pragma("unroll") for (int m = 0; m < 4; ++m) _Pragma("unroll") for (int k = 0; k < 2; ++k) dst[m][k] = *(const LAS bf16x8*)(lds + PG8_SA(b, h) + aoff + m * 2048 + k * 1024); } while (0)
#define PG8_LDB(dst, b, h) do { _Pragma("unroll") for (int n = 0; n < 2; ++n) _Pragma("unroll") for (int k = 0; k < 2; ++k) dst[n][k] = *(const LAS bf16x8*)(lds + PG8_SB(b, h) + boff + n * 2048 + k * 1024); } while (0)
#define PG8_MMA(ai, bj, At, Bt) do { __builtin_amdgcn_s_setprio(1); _Pragma("unroll") for (int m = 0; m < 4; ++m) _Pragma("unroll") for (int n = 0; n < 2; ++n) _Pragma("unroll") for (int k = 0; k < 2; ++k) \
        acc[ai][bj][m][n] = __builtin_amdgcn_mfma_f32_16x16x32_bf16(Bt[n][k], At[m][k], acc[ai][bj][m][n], 0, 0, 0); __builtin_amdgcn_s_setprio(0); } while (0)
#define PG8_WAIT_V(n) asm volatile("s_waitcnt vmcnt(" #n ")" ::: "memory")
#define PG8_WAIT_L(n) asm volatile("s_waitcnt lgkmcnt(" #n ")" ::: "memory")
#define PG8_BAR __builtin_amdgcn_s_barrier()
#define PG8_SCHED __builtin_amdgcn_sched_barrier(0)
    Unit cur, nxt; int ui = 0;
    if (!S.next(0, cur)) return;
    f32x4 acc[2][2][4][2];
#pragma unroll
    for (int a = 0; a < 2; ++a)
#pragma unroll
        for (int b = 0; b < 2; ++b)
#pragma unroll
            for (int m = 0; m < 4; ++m)
#pragma unroll
                for (int n = 0; n < 2; ++n) acc[a][b][m][n] = (f32x4){0.f, 0.f, 0.f, 0.f};
    bf16x8 At[4][2], B0[2][2], B1[2][2];
    const char* cA = (const char*)g.A + (size_t)cur.pm * tstepA; const char* cB = (const char*)g.Bt + (size_t)cur.pn * tstepB;
    LAS float* rsl = (LAS float*)(lds + STAGE_BYTES);
    PG8_STAGE(PG8_SB(0, 0), cB, voffB); PG8_STAGE(PG8_SA(0, 0), cA, voffA); PG8_STAGE(PG8_SB(0, 1), cB + hstepB, voffB); PG8_STAGE(PG8_SA(0, 1), cA + hstepA, voffA);
    if (wr == 1) PG8_BAR;
    PG8_WAIT_V(4); PG8_BAR;
    PG8_STAGE(PG8_SB(1, 0), cB + kstep, voffB); PG8_STAGE(PG8_SA(1, 0), cA + kstep, voffA); PG8_STAGE(PG8_SB(1, 1), cB + hstepB + kstep, voffB);
    PG8_WAIT_V(6); PG8_BAR;
    for (;;) {
        const bool has_next = S.next(ui + 1, nxt);
        const char* nA = has_next ? (const char*)g.A + (size_t)nxt.pm * tstepA : cA; const char* nB = has_next ? (const char*)g.Bt + (size_t)nxt.pn * tstepB : cB;
        for (int t = 0; t < nt; t += 2) {
            const bool last = (t == nt - 2);
            const char* a1 = cA + (size_t)(t + 1) * kstep;
            const char* a2 = last ? nA : cA + (size_t)(t + 2) * kstep; const char* b2 = last ? nB : cB + (size_t)(t + 2) * kstep;
            const char* a3 = a2 + kstep; const char* b3 = b2 + kstep;
            if (E.rowscale() && t == 0 && wid < 4) __builtin_amdgcn_global_load_lds((const unsigned*)(E.row_ptr() + cur.pm * 256 + tid), (LAS unsigned*)(rsl + (ui & 1) * 256 + wid * 64), 4, 0, 0);
            PG8_LDB(B0, 0, 0); PG8_SCHED; PG8_LDA(At, 0, 0); PG8_STAGE(PG8_SA(1, 1), a1 + hstepA, voffA);
            PG8_WAIT_L(8); PG8_BAR; PG8_WAIT_L(0); PG8_MMA(0, 0, At, B0); PG8_BAR; PG8_SCHED;
            PG8_LDB(B1, 0, 1); PG8_STAGE(PG8_SB(0, 0), b2, voffB);
            PG8_BAR; PG8_WAIT_L(0); PG8_MMA(0, 1, At, B1); PG8_BAR;
            PG8_LDA(At, 0, 1); PG8_STAGE(PG8_SA(0, 0), a2, voffA);
            PG8_BAR; PG8_WAIT_L(0); PG8_MMA(1, 0, At, B0); PG8_BAR; PG8_SCHED;
            PG8_STAGE(PG8_SB(0, 1), b2 + hstepB, voffB);
            PG8_WAIT_V(6); PG8_BAR; PG8_MMA(1, 1, At, B1); PG8_BAR;
            PG8_LDB(B0, 1, 0); PG8_SCHED; PG8_LDA(At, 1, 0); PG8_STAGE(PG8_SA(0, 1), a2 + hstepA, voffA);
            PG8_WAIT_L(8); PG8_BAR; PG8_WAIT_L(0); PG8_MMA(0, 0, At, B0); PG8_BAR; PG8_SCHED;
            PG8_LDB(B1, 1, 1); PG8_STAGE(PG8_SB(1, 0), b3, voffB);
            PG8_BAR; PG8_WAIT_L(0); PG8_MMA(0, 1, At, B1); PG8_BAR;
            PG8_LDA(At, 1, 1); PG8_STAGE(PG8_SA(1, 0), a3, voffA);
            PG8_BAR; PG8_WAIT_L(0); PG8_MMA(1, 0, At, B0); PG8_BAR; PG8_SCHED;
            PG8_STAGE(PG8_SB(1, 1), b3 + hstepB, voffB);
            PG8_WAIT_V(6); PG8_BAR; PG8_MMA(1, 1, At, B1); PG8_BAR;
        }
        E(acc, cur, wr, wc, fr, fq, rsl + (ui & 1) * 256);
        if (!has_next) break;
#pragma unroll
        for (int a = 0; a < 2; ++a)
#pragma unroll
            for (int b = 0; b < 2; ++b)
#pragma unroll
                for (int m = 0; m < 4; ++m)
#pragma unroll
                    for (int n = 0; n < 2; ++n) acc[a][b][m][n] = (f32x4){0.f, 0.f, 0.f, 0.f};
        cur = nxt; cA = nA; cB = nB; ++ui;
    }
    PG8_WAIT_V(0);
    if (wr == 0) PG8_BAR;
    PG8_BAR;
#undef PG8_SA
#undef PG8_SB
#undef PG8_STAGE
#undef PG8_LDA
#undef PG8_LDB
#undef PG8_MMA
#undef PG8_WAIT_V
#undef PG8_WAIT_L
#undef PG8_BAR
#undef PG8_SCHED
}
}
using pg8::Unit;

__device__ __forceinline__ void store8bf(bf16_t* p, f32x4 v0, f32x4 v1) {
    u32x4 w; w.x = cvt_pk_bf16(v0[0], v0[1]); w.y = cvt_pk_bf16(v0[2], v0[3]); w.z = cvt_pk_bf16(v1[0], v1[1]); w.w = cvt_pk_bf16(v1[2], v1[3]);
    *(u32x4*)p = w;
}
__device__ __forceinline__ void store8bf_nt(bf16_t* p, f32x4 v0, f32x4 v1) {
    u32x4 w; w.x = cvt_pk_bf16(v0[0], v0[1]); w.y = cvt_pk_bf16(v0[2], v0[3]); w.z = cvt_pk_bf16(v1[0], v1[1]); w.w = cvt_pk_bf16(v1[2], v1[3]);
    __builtin_nontemporal_store(w, (u32x4*)p);
}
struct Epi1 {
    static constexpr bool PERM = true;
    bf16_t* proj; float* dt; const float* ssq;
    __device__ __forceinline__ void operator()(const f32x4 (&acc)[2][2][4][2], const Unit& u, int wr, int wc, int fr, int fq, const LAS float* rsl) const {
        const int row0 = u.pm * 256 + wr * 64 + fr, pn = u.pn;
        float rs[2][4];
#pragma unroll
        for (int ai = 0; ai < 2; ++ai)
#pragma unroll
            for (int m = 0; m < 4; ++m) rs[ai][m] = rsl[wr * 64 + fr + ai * 128 + m * 16];
#pragma unroll
        for (int ai = 0; ai < 2; ++ai)
#pragma unroll
            for (int m = 0; m < 4; ++m) {
                const int row = row0 + ai * 128 + m * 16;
                const float rstd = rsqrtf(rs[ai][m] * (1.f / 1024.f) + EPS);
                bf16_t* rp = proj + (size_t)row * PW + wc * 32 + 8 * fq;
                if (pn < 9) {
#pragma unroll
                    for (int bj = 0; bj < 2; ++bj) store8bf_nt(rp + pn * 256 + bj * 128, acc[ai][bj][m][0] * rstd, acc[ai][bj][m][1] * rstd);
                } else if (pn < 17) {
                    f32x4 b0 = acc[ai][0][m][0] * rstd, b1 = acc[ai][0][m][1] * rstd, z0 = acc[ai][1][m][0] * rstd, z1 = acc[ai][1][m][1] * rstd;
#pragma unroll
                    for (int j = 0; j < 4; ++j) { float sa, sb; sigmoid2(z0[j], z1[j], sa, sb); b0[j] *= z0[j] * sa; b1[j] *= z1[j] * sb; }
                    store8bf_nt(rp + COL_BZ + (pn - 9) * 128, b0, b1);
                } else if (pn < 25) {
                    const float r2 = rstd * rstd;
                    store8bf_nt(rp + COL_HC + (pn - 17) * 128, acc[ai][0][m][0] * acc[ai][1][m][0] * r2, acc[ai][0][m][1] * acc[ai][1][m][1] * r2);
                } else if (wc == 0 && fq < 2) {
                    float* dp = dt + (size_t)row * 16 + 8 * fq;
                    *(f32x4*)dp = acc[ai][0][m][0] * rstd; *(f32x4*)(dp + 4) = acc[ai][0][m][1] * rstd;
                }
                if (m & 1) asm volatile("" ::: "memory");
            }
    }
};
struct EpiPlain {
    static constexpr bool PERM = true;
    bf16_t* O; int ldc;
    __device__ __forceinline__ void operator()(const f32x4 (&acc)[2][2][4][2], const Unit& u, int wr, int wc, int fr, int fq, const LAS float* rsl) const {
        const int row0 = u.pm * 256 + wr * 64 + fr, col0 = u.pn * 256 + wc * 32 + 8 * fq;
#pragma unroll
        for (int ai = 0; ai < 2; ++ai)
#pragma unroll
            for (int m = 0; m < 4; ++m) { bf16_t* rp = O + (size_t)(row0 + ai * 128 + m * 16) * ldc + col0;
#pragma unroll
                for (int bj = 0; bj < 2; ++bj) store8bf(rp + bj * 128, acc[ai][bj][m][0], acc[ai][bj][m][1]);
                if (m & 1) asm volatile("" ::: "memory"); }
    }
};
struct Epi2 {
    static constexpr bool PERM = true;
    bf16_t* O; float* ssq;
    __device__ __forceinline__ void operator()(const f32x4 (&acc)[2][2][4][2], const Unit& u, int wr, int wc, int fr, int fq, const LAS float* rsl) const {
        const int row0 = u.pm * 256 + wr * 64 + fr, col0 = u.pn * 256 + wc * 32 + 8 * fq;
#pragma unroll
        for (int ai = 0; ai < 2; ++ai)
#pragma unroll
            for (int m = 0; m < 4; ++m) { const int row = row0 + ai * 128 + m * 16; bf16_t* rp = O + (size_t)row * 1024 + col0; float s = 0.f;
#pragma unroll
                for (int bj = 0; bj < 2; ++bj) { const f32x4 v0 = acc[ai][bj][m][0], v1 = acc[ai][bj][m][1]; store8bf(rp + bj * 128, v0, v1);
#pragma unroll
                    for (int j = 0; j < 4; ++j) s += v0[j] * v0[j] + v1[j] * v1[j]; }
                s += __shfl_xor(s, 16); s += __shfl_xor(s, 32);
                if (fq == 0) atomicAdd(ssq + row, s);
                if (m & 1) asm volatile("" ::: "memory"); }
    }
};
struct Epi3 {
    static constexpr bool PERM = true;
    float* X; const bf16_t* pp; bf16_t* xb; float* ssq; const bf16_t* x1b;
    __device__ __forceinline__ void operator()(const f32x4 (&acc)[2][2][4][2], const Unit& u, int wr, int wc, int fr, int fq, const LAS float* rsl) const {
        const int row0 = u.pm * 256 + wr * 64 + fr, col0 = u.pn * 256 + wc * 32 + 8 * fq;
        u32x4 xr[2][2], pr[2][2];
#pragma unroll
        for (int bj = 0; bj < 2; ++bj) { const size_t off = (size_t)row0 * 1024 + col0 + bj * 128; xr[0][bj] = *(const u32x4*)(x1b + off); pr[0][bj] = *(const u32x4*)(pp + off); }
#pragma unroll
        for (int ai = 0; ai < 2; ++ai)
#pragma unroll
            for (int m = 0; m < 4; ++m) { const int row = row0 + ai * 128 + m * 16; float s = 0.f; const int bt = ai * 4 + m;
                if (bt < 7) { const int nrow = row0 + ((bt + 1) >> 2) * 128 + ((bt + 1) & 3) * 16;
#pragma unroll
                    for (int bj = 0; bj < 2; ++bj) { const size_t off = (size_t)nrow * 1024 + col0 + bj * 128; xr[(bt + 1) & 1][bj] = *(const u32x4*)(x1b + off); pr[(bt + 1) & 1][bj] = *(const u32x4*)(pp + off); } }
#pragma unroll
                for (int bj = 0; bj < 2; ++bj) { const size_t off = (size_t)row * 1024 + col0 + bj * 128;
                    float xv[8], pv[8]; unpack8(xr[bt & 1][bj], xv); unpack8(pr[bt & 1][bj], pv);
                    f32x4 x0 = (f32x4){xv[0], xv[1], xv[2], xv[3]}, x1 = (f32x4){xv[4], xv[5], xv[6], xv[7]};
                    const f32x4 g0 = acc[ai][bj][m][0], g1 = acc[ai][bj][m][1];
#pragma unroll
                    for (int j = 0; j < 4; ++j) { float sa, sb; sigmoid2(g0[j], g1[j], sa, sb); x0[j] += sa * pv[j]; x1[j] += sb * pv[4 + j]; s += x0[j] * x0[j] + x1[j] * x1[j]; }
                    if (xb) store8bf(xb + off, x0, x1);
                    else { *(f32x4*)(X + off) = x0; *(f32x4*)(X + off + 4) = x1; } }
                if (xb) { s += __shfl_xor(s, 16); s += __shfl_xor(s, 32); if (fq == 0) atomicAdd(ssq + row, s); }
                asm volatile("" ::: "memory"); }
    }
};

struct EpiAll {
    static constexpr bool PERM = true;
    int mode, layer; unsigned char* ws; float* out;
    __device__ __forceinline__ bool rowscale() const { return mode == 0; }
    __device__ __forceinline__ const float* row_ptr() const { return (const float*)(ws + OFF_SSQ); }
    __device__ __forceinline__ void operator()(const f32x4 (&acc)[2][2][4][2], const Unit& u, int wr, int wc, int fr, int fq, const LAS float* rsl) const {
        if (mode == 0) { const Epi1 e{(bf16_t*)(ws + OFF_PROJ), (float*)(ws + OFF_DT), (const float*)(ws + OFF_SSQ)}; e(acc, u, wr, wc, fr, fq, rsl); }
        else if (mode == 1) { const EpiPlain e{(bf16_t*)(ws + OFF_PP), 1024}; e(acc, u, wr, wc, fr, fq, rsl); }
        else if (mode == 2) { const Epi2 e{(bf16_t*)out, (float*)(ws + OFF_SSQ2)}; e(acc, u, wr, wc, fr, fq, rsl); }
        else { const Epi3 e{out, (const bf16_t*)(ws + OFF_PP), layer == 0 ? (bf16_t*)(ws + OFF_XB) : nullptr, (float*)(ws + OFF_SSQ), (const bf16_t*)(ws + OFF_PROJ)}; e(acc, u, wr, wc, fr, fq, rsl); }
    }
};

__device__ __forceinline__ void transpose_tile_wave(const float* src, int ld, int k0, int c0, int valid, const float* rs, bf16_t* dst, int ldd, int j0, int lane) {
    const float* sp = src + (size_t)k0 * ld + c0 + lane; const bool ok = lane < valid;
    bf16_t* dp = dst + (size_t)(j0 + lane) * ldd + k0;
    { float v[64];
#pragma unroll
        for (int i = 0; i < 64; ++i) v[i] = ok ? __builtin_nontemporal_load(sp + (size_t)i * ld) : 0.f;
        if (rs) {
#pragma unroll
            for (int i = 0; i < 64; ++i) v[i] *= rs[k0 + i]; }
#pragma unroll
        for (int o = 0; o < 8; ++o) { u32x4 w; w.x = cvt_pk_bf16(v[o * 8 + 0], v[o * 8 + 1]); w.y = cvt_pk_bf16(v[o * 8 + 2], v[o * 8 + 3]); w.z = cvt_pk_bf16(v[o * 8 + 4], v[o * 8 + 5]); w.w = cvt_pk_bf16(v[o * 8 + 6], v[o * 8 + 7]);
            *(u32x4*)(dp + o * 8) = w; } }
}
__device__ void phase_prologue(KP P, LAS unsigned char* lds) {
    unsigned char* ws = P->ws; (void)lds;
    const int tid = opaque_tid(), lane = tid & 63;
    const int gw = blockIdx.x * 8 + (tid >> 6), nw = opaque_nblk() * 8;
    for (int job = gw; job < 4992; job += nw) {
        if (job < 3328) { const int l = job / 1664, r = job % 1664, jt = r >> 4, kt = r & 15, j0 = jt * 64; int src, valid = 64;
            if (j0 < 1280) src = j0;
            else if (j0 < 2304) src = 1296 + (j0 - 1280);
            else if (j0 < 4352) { const int i = (j0 - 2304) >> 8, w = (j0 - 2304) & 255; src = (w < 128) ? 3344 + 128 * i + w : 5392 + 128 * i + (w - 128); }
            else if (j0 < 6400) { const int i = (j0 - 4352) >> 8, w = (j0 - 4352) & 255; src = (w < 128) ? 2320 + 128 * i + w : 4368 + 128 * i + (w - 128); }
            else if (j0 == 6400) { src = 1280; valid = 16; }
            else { src = 0; valid = 0; }
            transpose_tile_wave(P->w_in + (size_t)l * 1024 * 6416, 6416, kt * 64, src, valid, P->norm_pre + l * 1024, (bf16_t*)(ws + OFF_BTIN) + (size_t)l * NIN * 1024, 1024, j0, lane);
        } else if (job < 4352) { const int q = job - 3328, l = q >> 9, r = q & 511, ntile = r >> 5, kt = r & 31;
            transpose_tile_wave(P->w_out + (size_t)l * 2048 * 1024, 1024, kt * 64, ntile * 64, 64, nullptr, (bf16_t*)(ws + OFF_BTOUT) + (size_t)l * 1024 * 2048, 2048, ntile * 64, lane);
        } else if (job < 4864) { const int q = job - 4352, l = q >> 8, r = q & 255, ntile = r >> 4, kt = r & 15;
            transpose_tile_wave(P->w_g + (size_t)l * 1024 * 1024, 1024, kt * 64, ntile * 64, 64, nullptr, (bf16_t*)(ws + OFF_BTG) + (size_t)l * 1024 * 1024, 1024, ntile * 64, lane);
        } else { const int q = job - 4864, l = q >> 6, r = q & 63, ntile = r >> 2, kt = r & 3;
            transpose_tile_wave(P->w_p + (size_t)l * 256 * 1024, 1024, kt * 64, ntile * 64, 64, nullptr, (bf16_t*)(ws + OFF_BTP) + (size_t)l * 1024 * 256, 256, ntile * 64, lane);
        }
    }
    bf16_t* xb = (bf16_t*)(ws + OFF_XB); float* ssq = (float*)(ws + OFF_SSQ);
#pragma unroll 8
    for (int row = gw; row < MTOK; row += nw) { float s = 0.f;
#pragma unroll
        for (int i = 0; i < 4; ++i) { const int col = lane * 4 + 256 * i; const f32x4 v = __builtin_nontemporal_load((const f32x4*)(P->x + (size_t)row * 1024 + col));
            s += v.x * v.x + v.y * v.y + v.z * v.z + v.w * v.w; u32x2 w; w.x = cvt_pk_bf16(v.x, v.y); w.y = cvt_pk_bf16(v.z, v.w); *(u32x2*)(xb + (size_t)row * 1024 + col) = w; }
#pragma unroll
        for (int d = 32; d >= 1; d >>= 1) s += __shfl_xor(s, d);
        if (lane == 0) ssq[row] = s; }
    bf16_t* pb = (bf16_t*)(ws + OFF_PB);
#pragma unroll 16
    for (size_t i = (size_t)blockIdx.x * 512 + tid; i < (size_t)2 * MTOK * 256 / 4; i += (size_t)nw * 64) {
        const f32x4 v = __builtin_nontemporal_load((const f32x4*)(P->p + i * 4)); u32x2 w; w.x = cvt_pk_bf16(v.x, v.y); w.y = cvt_pk_bf16(v.z, v.w); *(u32x2*)(pb + i * 4) = w; }
}

__device__ __forceinline__ void conv8_nat(const bf16_t* proj, long row0, int tbase, int l, int ch, const float* cw, const float* cb, float (&o)[8]) {
    { const f32x4 b0 = *(const f32x4*)(cb + ch), b1 = *(const f32x4*)(cb + ch + 4);
#pragma unroll
      for (int j = 0; j < 4; ++j) { o[j] = b0[j]; o[4 + j] = b1[j]; } }
#pragma unroll
    for (int k = 0; k < 4; ++k) { const int tl = l - 3 + k;
        if (tbase + tl >= 0) { float v[8]; unpack8(*(const u32x4*)(proj + (row0 + tl) * PW + ch), v);
            const f32x4 w0 = *(const f32x4*)(cw + k * 1280 + ch), w1 = *(const f32x4*)(cw + k * 1280 + ch + 4);
#pragma unroll
            for (int j = 0; j < 4; ++j) { o[j] += w0[j] * v[j]; o[4 + j] += w1[j] * v[4 + j]; } } }
#pragma unroll
    for (int j = 0; j < 8; ++j) o[j] = silu_f(o[j]);
}
typedef float f32x2 __attribute__((ext_vector_type(2)));
__device__ __forceinline__ __amdgpu_buffer_rsrc_t seq_rsrc(const bf16_t* proj, long row0, int tbase) {
    return __builtin_amdgcn_make_buffer_rsrc((void*)(proj + (row0 - tbase) * PW), (short)0, (int)(SEQ * PW * 2), 0x00020000);
}
__device__ __forceinline__ void conv8_load(__amdgpu_buffer_rsrc_t rs, int tbase, int l, int ch, u32x4 (&raw)[4]) {
    const int voff = ((tbase + l - 3) * PW + ch) * 2;
#pragma unroll
    for (int k = 0; k < 4; ++k) raw[k] = __builtin_amdgcn_raw_buffer_load_b128(rs, voff + k * (PW * 2), 0, 0);
}
__device__ __forceinline__ void conv8_math(const u32x4 (&raw)[4], const float (&w)[4][8], const float (&bias)[8], float (&o)[8]);
__device__ __forceinline__ void conv8_w(__amdgpu_buffer_rsrc_t rs, int tbase, int l, int ch, const float (&w)[4][8], const float (&bias)[8], float (&o)[8]) {
    u32x4 raw[4]; conv8_load(rs, tbase, l, ch, raw); conv8_math(raw, w, bias, o);
}
__device__ __forceinline__ void conv8_math(const u32x4 (&raw)[4], const float (&w)[4][8], const float (&bias)[8], float (&o)[8]) {
    f32x2 a[4];
#pragma unroll
    for (int j = 0; j < 4; ++j) a[j] = (f32x2){bias[2 * j], bias[2 * j + 1]};
#pragma unroll
    for (int k = 0; k < 4; ++k) {
#pragma unroll
        for (int j = 0; j < 4; ++j) { const unsigned u = raw[k][j]; const f32x2 v = (f32x2){bflo(u), bfhi(u)}, wv = (f32x2){w[k][2 * j], w[k][2 * j + 1]}; a[j] = wv * v + a[j]; } }
#pragma unroll
    for (int j = 0; j < 4; ++j) { float sa, sb; sigmoid2(a[j].x, a[j].y, sa, sb); o[2 * j] = a[j].x * sa; o[2 * j + 1] = a[j].y * sb; }
}
__device__ __forceinline__ void load_conv_w(const float* cw, const float* cb, int ch, float (&w)[4][8], float (&bias)[8]) {
#pragma unroll
    for (int k = 0; k < 4; ++k) { const f32x4 a = *(const f32x4*)(cw + k * 1280 + ch), b = *(const f32x4*)(cw + k * 1280 + ch + 4);
#pragma unroll
        for (int j = 0; j < 4; ++j) { w[k][j] = a[j]; w[k][4 + j] = b[j]; } }
    const f32x4 a = *(const f32x4*)(cb + ch), b = *(const f32x4*)(cb + ch + 4);
#pragma unroll
    for (int j = 0; j < 4; ++j) { bias[j] = a[j]; bias[4 + j] = b[j]; }
}
template <int N>
__device__ __forceinline__ void conv_tok(const bf16_t* pch, long row0, int tbase, int lstart, const float (&w)[4], float bias, float* o) {
    float v[N + 3];
#pragma unroll
    for (int j = 0; j < N + 3; ++j) { const int tl = lstart - 3 + j; v[j] = (tbase + tl >= 0) ? bf2f(pch[(row0 + tl) * PW]) : 0.f; }
#pragma unroll
    for (int i = 0; i < N; ++i) o[i] = silu_f(bias + w[0] * v[i] + w[1] * v[i + 1] + w[2] * v[i + 2] + w[3] * v[i + 3]);
}
__device__ __forceinline__ void dt_cumsum(const float* dtb, long row0, int h, float bias, float A, int lane, float& d0, float& d1, float& cs0, float& cs1, float& tot) {
    d0 = softplus_f(dtb[(row0 + 2 * lane) * 16 + h] + bias); d1 = softplus_f(dtb[(row0 + 2 * lane + 1) * 16 + h] + bias);
    const float a1 = d1 * A; float v = d0 * A + a1;
#pragma unroll
    for (int d = 1; d < 64; d <<= 1) { const float t = __shfl_up(v, d); if (lane >= d) v += t; }
    tot = __shfl(v, 63); cs1 = v; cs0 = v - a1;
}

__device__ void phase_states(KP P, int layer, LAS unsigned char* lds) {
    const int tid = opaque_tid(), wid = tid >> 6, lane = tid & 63, r = lane & 15, q = lane >> 4;
    LAS bf16_t* BcT = (LAS bf16_t*)lds;
    LAS float* wgt = (LAS float*)(lds + 17408);
    LAS unsigned char* xsw = lds + 21504 + wid * 16384;
    const bf16_t* proj = (const bf16_t*)(P->ws + OFF_PROJ); const float* dtb = (const float*)(P->ws + OFF_DT);
    bf16_t* states = (bf16_t*)(P->ws + OFF_ST); float* totals = (float*)(P->ws + OFF_TOT);
    const float* cw = P->conv_w + layer * 4 * 1280; const float* cb = P->conv_b + layer * 1280;
    const int nblk = opaque_nblk();
    for (int item = blockIdx.x; item < 512; item += nblk) {
        const int g = item & 1, bc = item >> 1, b = bc >> 6, c = bc & 63, tbase = c * 128, h = g * 8 + wid;
        const long row0 = (long)b * SEQ + tbase;
        const __amdgpu_buffer_rsrc_t rsq = seq_rsrc(proj, row0, tbase);
        u32x4 rbb[2][4];
#pragma unroll
        for (int i = 0; i < 2; ++i) conv8_load(rsq, tbase, (tid >> 3) + 64 * i, 1024 + g * 64 + (tid & 7) * 8, rbb[i]);
        { float d0, d1, cs0, cs1, tot; dt_cumsum(dtb, row0, h, P->dt_bias[layer * 16 + h], -expf(P->a_log[layer * 16 + h]), lane, d0, d1, cs0, cs1, tot);
          { f32x2* dcs = (f32x2*)P->out; dcs[(row0 + 2 * lane) * 16 + h] = (f32x2){d0, cs0}; dcs[(row0 + 2 * lane + 1) * 16 + h] = (f32x2){d1, cs1}; }
          wgt[wid * 128 + 2 * lane] = d0 * __expf(tot - cs0); wgt[wid * 128 + 2 * lane + 1] = d1 * __expf(tot - cs1);
          if (lane == 0) totals[bc * 16 + h] = tot; }
        {
            float w[4][8], bias[8]; const int cgp = tid & 7; load_conv_w(cw, cb, 1024 + g * 64 + cgp * 8, w, bias);
#pragma unroll
            for (int i = 0; i < 2; ++i) { const int l = (tid >> 3) + 64 * i; float o[8]; conv8_math(rbb[i], w, bias, o);
#pragma unroll
                for (int e = 0; e < 8; e += 2) { const unsigned pk = cvt_pk_bf16(o[e], o[e + 1]);
                    BcT[(cgp * 8 + e) * 136 + (l ^ (cgp << 3))] = (bf16_t)pk; BcT[(cgp * 8 + e + 1) * 136 + (l ^ (cgp << 3))] = (bf16_t)(pk >> 16); } }
        }
        {
            float w[4][8], bias[8]; const int cgp = lane & 7; load_conv_w(cw, cb, h * 64 + cgp * 8, w, bias);
            asm volatile("s_waitcnt lgkmcnt(0)" ::: "memory");
            u32x4 rawb[2][4][4];
#pragma unroll
            for (int t = 0; t < 4; ++t) conv8_load(rsq, tbase, (lane >> 3) + 8 * t, h * 64 + cgp * 8, rawb[0][t]);
#pragma unroll
            for (int i = 0; i < 16; ++i) { const int l = (lane >> 3) + 8 * i; float o[8];
                if ((i & 3) == 0 && i < 12) {
#pragma unroll
                    for (int t = 0; t < 4; ++t) conv8_load(rsq, tbase, (lane >> 3) + 8 * (i + 4 + t), h * 64 + cgp * 8, rawb[((i >> 2) + 1) & 1][t]); }
                conv8_math(rawb[(i >> 2) & 1][i & 3], w, bias, o);
                if ((i & 3) == 3) asm volatile("" ::: "memory");
                const float wl = wgt[wid * 128 + l];
                LAS unsigned char* dst = xsw + ((cgp >> 1) * 4 + (l >> 5)) * 1024 + (((cgp & 1) * 8) + 16 * ((l & 31) >> 3)) * 16 + (l & 7) * 2;
#pragma unroll
                for (int e = 0; e < 8; e += 2) { const unsigned pk = cvt_pk_bf16(o[e] * wl, o[e + 1] * wl);
                    *(LAS bf16_t*)(dst + ((e ^ cgp) << 4)) = (bf16_t)pk; *(LAS bf16_t*)(dst + (((e + 1) ^ cgp) << 4)) = (bf16_t)(pk >> 16); } }
        }
        __syncthreads();
        f32x4 acc[4][4];
#pragma unroll
        for (int a = 0; a < 4; ++a)
#pragma unroll
            for (int n = 0; n < 4; ++n) acc[a][n] = (f32x4){0.f, 0.f, 0.f, 0.f};
#pragma unroll 1
        for (int ks = 0; ks < 4; ++ks) { const int lb = ks * 32 + q * 8;
            bf16x8 af[4], bfr[4];
#pragma unroll
            for (int pt = 0; pt < 4; ++pt) af[pt] = *(const LAS bf16x8*)(xsw + (pt * 4 + ks) * 1024 + ((lane ^ (2 * pt + (r >> 3))) << 4));
#pragma unroll
            for (int nt = 0; nt < 4; ++nt) bfr[nt] = *(const LAS bf16x8*)(BcT + (nt * 16 + r) * 136 + (lb ^ (((2 * nt + (r >> 3)) & 7) << 3)));
#pragma unroll
            for (int pt = 0; pt < 4; ++pt)
#pragma unroll
                for (int nt = 0; nt < 4; ++nt) acc[pt][nt] = __builtin_amdgcn_mfma_f32_16x16x32_bf16(bfr[nt], af[pt], acc[pt][nt], 0, 0, 0);
        }
        bf16_t* sp = states + (((size_t)bc * 16 + h) << 12);
#pragma unroll
        for (int pt = 0; pt < 4; ++pt)
#pragma unroll
            for (int nt = 0; nt < 4; ++nt)
                { u32x2 o; o.x = cvt_pk_bf16(acc[pt][nt][0], acc[pt][nt][1]); o.y = cvt_pk_bf16(acc[pt][nt][2], acc[pt][nt][3]); *(u32x2*)(sp + (pt * 16 + r) * 64 + nt * 16 + q * 4) = o; }
        __syncthreads();
    }
}

__device__ void phase_scan_sc(KP P, int layer) {
    const int tid = opaque_tid(); const int gtid = blockIdx.x * 512 + tid, gthreads = opaque_nblk() * 512;
    bf16_t* states = (bf16_t*)(P->ws + OFF_ST); const float* totals = (const float*)(P->ws + OFF_TOT);
    for (int e2 = gtid; e2 < 131072; e2 += gthreads) {
        const int b = e2 >> 15, rem = (e2 & 32767) * 2, h = rem >> 12;
        unsigned* p = (unsigned*)(states + (size_t)b * 64 * 65536 + rem);
        float r0 = 0.f, r1 = 0.f;
        for (int c0 = 0; c0 < 64; c0 += 16) { unsigned s[16]; float d[16];
#pragma unroll
            for (int i = 0; i < 16; ++i) { s[i] = p[(size_t)(c0 + i) * 32768]; d[i] = __expf(totals[(b * 64 + c0 + i) * 16 + h]); }
#pragma unroll
            for (int i = 0; i < 16; ++i) { p[(size_t)(c0 + i) * 32768] = cvt_pk_bf16(r0, r1); r0 = d[i] * r0 + bflo(s[i]); r1 = d[i] * r1 + bfhi(s[i]); } }
    }
    { float* ssq2 = (float*)(P->ws + OFF_SSQ2); for (int i = gtid; i < MTOK; i += gthreads) ssq2[i] = 0.f; }
    bf16_t* proj = (bf16_t*)(P->ws + OFF_PROJ); const float* w = P->sc_w + layer * 3 * 1024;
    for (int task = gtid; task < 2048 * 128; task += gthreads) {
        const int ch = (task & 127) * 8; const long rowS = (long)(task >> 7) * 16; const int tin = (int)(rowS & (SEQ - 1));
        float w0[8], w1[8], w2[8], hm2[8], hm1[8];
#pragma unroll
        for (int j = 0; j < 8; ++j) { w0[j] = w[ch + j]; w1[j] = w[1024 + ch + j]; w2[j] = w[2048 + ch + j]; hm2[j] = 0.f; hm1[j] = 0.f; }
        if (tin >= 2) { unpack8(*(const u32x4*)(proj + (rowS - 2) * PW + COL_HC + ch), hm2); unpack8(*(const u32x4*)(proj + (rowS - 1) * PW + COL_HC + ch), hm1); }
#pragma unroll
        for (int i = 0; i < 16; ++i) { float h0[8], bz[8]; bf16_t* bp = proj + (rowS + i) * PW + COL_BZ + ch;
            unpack8(__builtin_nontemporal_load((const u32x4*)(proj + (rowS + i) * PW + COL_HC + ch)), h0); unpack8(__builtin_nontemporal_load((const u32x4*)bp), bz);
            float y[8];
#pragma unroll
            for (int j = 0; j < 8; ++j) { y[j] = bz[j] * (w0[j] * hm2[j] + w1[j] * hm1[j] + w2[j] * h0[j]); hm2[j] = hm1[j]; hm1[j] = h0[j]; }
            *(u32x4*)bp = __builtin_bit_cast(u32x4, pack8(y)); }
    }
}

__device__ void phase_ssd_out(KP P, int layer, LAS unsigned char* lds) {
    const int tid = opaque_tid(), wid = tid >> 6, lane = tid & 63, r = lane & 15, q = lane >> 4;
    LAS bf16_t* Bc = (LAS bf16_t*)lds;
    LAS bf16_t* Cc = (LAS bf16_t*)(lds + 18432);
    LAS float* csA = (LAS float*)(lds + 36864);
    LAS float* dtA = (LAS float*)(lds + 40960);
    LAS float* red = (LAS float*)(lds + 45056);
    LAS unsigned char* xdL = lds + 49152;
    LAS float* fsA = (LAS float*)(lds + 114688);
    bf16_t* proj = (bf16_t*)(P->ws + OFF_PROJ); const float* dtb = (const float*)(P->ws + OFF_DT);
    const bf16_t* states = (const bf16_t*)(P->ws + OFF_ST);
    const float* cw = P->conv_w + layer * 4 * 1280; const float* cb = P->conv_b + layer * 1280;
    const int nblk = opaque_nblk();
    for (int item = blockIdx.x; item < 512; item += nblk) {
        const int g = item & 1, bc = item >> 1, b = bc >> 6, c = bc & 63, tbase = c * 128, h = g * 8 + wid;
        const long row0 = (long)b * SEQ + tbase;
        const __amdgpu_buffer_rsrc_t rsq = seq_rsrc(proj, row0, tbase);
        u32x4 rbc[4][4];
        { const int cg16 = tid & 15, chbc = 1024 + ((cg16 >> 3) * 128) + g * 64 + (cg16 & 7) * 8;
#pragma unroll
          for (int i = 0; i < 4; ++i) conv8_load(rsq, tbase, (tid >> 4) + 32 * i, chbc, rbc[i]); }
        { const f32x2* dcs = (const f32x2*)P->out; const f32x2 t0 = dcs[(row0 + 2 * lane) * 16 + h], t1 = dcs[(row0 + 2 * lane + 1) * 16 + h];
          const float d0 = t0.x, cs0 = t0.y, d1 = t1.x, cs1 = t1.y;
          csA[wid * 128 + 2 * lane] = cs0; csA[wid * 128 + 2 * lane + 1] = cs1; dtA[wid * 128 + 2 * lane] = d0; dtA[wid * 128 + 2 * lane + 1] = d1;
          const float ce = __shfl(cs1, (lane & 48) | 15);
          fsA[wid * 128 + 2 * lane] = __expf(ce - cs0); fsA[wid * 128 + 2 * lane + 1] = __expf(ce - cs1); }
        {
            float w[4][8], bias[8]; const int cgp = tid & 15, ch = 1024 + ((cgp >> 3) * 128) + g * 64 + (cgp & 7) * 8; load_conv_w(cw, cb, ch, w, bias);
            LAS bf16_t* dstb = ((cgp >> 3) ? Cc : Bc) + (cgp & 7) * 8;
#pragma unroll
            for (int i = 0; i < 4; ++i) { const int l = (tid >> 4) + 32 * i; float o[8]; conv8_math(rbc[i], w, bias, o);
                *(LAS u32x4*)(dstb + l * 72) = __builtin_bit_cast(u32x4, pack8(o)); }
        }
        __syncthreads();
        const float Dh = P->d_skip[layer * 16 + h];
        const LAS float* csw = csA + wid * 128; const LAS float* dtw = dtA + wid * 128; const LAS float* fsw = fsA + wid * 128;
        const bf16_t* stp = states + (((size_t)bc * 16 + h) << 12);
        bf16_t* zbase = proj + row0 * PW + COL_Z + h * 64;
        LAS unsigned char* xdw = xdL + wid * 8192;
        const int xsl = (lane ^ ((r >> 3) + 2 * q)) << 4;
#pragma unroll 1
        for (int ph = 0; ph < 2; ++ph) {
            {
                float w[4][8], bias[8]; const int cgp = lane & 3, ch = h * 64 + ph * 32 + cgp * 8; load_conv_w(cw, cb, ch, w, bias);
                u32x4 rawb[2][4][4];
#pragma unroll
                for (int t4 = 0; t4 < 4; ++t4) conv8_load(rsq, tbase, (lane >> 2) + 16 * t4, ch, rawb[0][t4]);
#pragma unroll
                for (int i = 0; i < 8; ++i) { const int l = (lane >> 2) + 16 * i; float o[8];
                    if (i == 0) {
#pragma unroll
                        for (int t4 = 0; t4 < 4; ++t4) conv8_load(rsq, tbase, (lane >> 2) + 16 * (4 + t4), ch, rawb[1][t4]); }
                    conv8_math(rawb[i >> 2][i & 3], w, bias, o);
                    if (i == 3) asm volatile("" ::: "memory");
                    const float dl = dtw[l]; const int t = l & 31;
                    LAS unsigned char* dst = xdw + ((l >> 5) * 2 + (cgp >> 1)) * 1024 + (((cgp & 1) * 8) + 16 * ((t & 15) >> 2)) * 16 + ((t & 3) + 4 * (t >> 4)) * 2;
                    const int swz = (cgp & 1) + 2 * ((t & 15) >> 2);
#pragma unroll
                    for (int e = 0; e < 8; e += 2) { const unsigned pk = cvt_pk_bf16(o[e] * dl, o[e + 1] * dl);
                        *(LAS bf16_t*)(dst + ((e ^ swz) << 4)) = (bf16_t)pk; *(LAS bf16_t*)(dst + (((e + 1) ^ swz) << 4)) = (bf16_t)(pk >> 16); } }
            }
            LAS unsigned char* bpw = lds + 118784 + wid * 4096 + lane * 16;
#pragma unroll
            for (int pt2 = 0; pt2 < 2; ++pt2)
#pragma unroll
                for (int ks = 0; ks < 2; ++ks) *(LAS bf16x8*)(bpw + (pt2 * 2 + ks) * 1024) = *(const bf16x8*)(stp + ((2 * ph + pt2) * 16 + r) * 64 + ks * 32 + q * 8);
            bf16_t* zl = zbase + (long)r * PW + ph * 32 + q * 4;
#pragma unroll 1
            for (int ltp = 0; ltp < 4; ++ltp) {
                u32x2 zv[2][2]; bf16x8 cf[2][2]; f32x4 acc[2][2]; float csl[2], dsk[2]; int lrow[2];
#pragma unroll
                for (int u = 0; u < 2; ++u) { const int lt = 2 * ltp + u, l = lt * 16 + r; lrow[u] = l;
                    zv[u][0] = *(const u32x2*)(zl + (long)lt * 16 * PW); zv[u][1] = *(const u32x2*)(zl + (long)lt * 16 * PW + 16);
                    cf[u][0] = *(const LAS bf16x8*)(Cc + l * 72 + q * 8); cf[u][1] = *(const LAS bf16x8*)(Cc + l * 72 + 32 + q * 8);
                    csl[u] = csw[l]; dsk[u] = Dh * __builtin_amdgcn_rcpf(dtw[l]); }
#pragma unroll
                for (int u = 0; u < 2; ++u)
#pragma unroll
                    for (int pt2 = 0; pt2 < 2; ++pt2) { f32x4 a = (f32x4){0.f, 0.f, 0.f, 0.f};
                        a = __builtin_amdgcn_mfma_f32_16x16x32_bf16(*(const LAS bf16x8*)(bpw + (pt2 * 2) * 1024), cf[u][0], a, 0, 0, 0); a = __builtin_amdgcn_mfma_f32_16x16x32_bf16(*(const LAS bf16x8*)(bpw + (pt2 * 2 + 1) * 1024), cf[u][1], a, 0, 0, 0);
                        acc[u][pt2] = a * __expf(csl[u]); }
#pragma unroll 2
                for (int sp = 0; sp <= ltp; ++sp) { const int sA = sp * 32 + q * 4, sB = sA + 16;
                    const f32x4 csa = *(const LAS f32x4*)(csw + sA), csb = *(const LAS f32x4*)(csw + sB);
                    const LAS bf16_t* bq = Bc + (sp * 32 + r) * 72 + q * 8;
                    const bf16x8 a00 = *(const LAS bf16x8*)bq, a01 = *(const LAS bf16x8*)(bq + 32), a10 = *(const LAS bf16x8*)(bq + 16 * 72), a11 = *(const LAS bf16x8*)(bq + 16 * 72 + 32);
                    const bf16x8 bx0 = *(const LAS bf16x8*)(xdw + (sp * 2) * 1024 + xsl), bx1 = *(const LAS bf16x8*)(xdw + (sp * 2 + 1) * 1024 + xsl);
                    f32x4 g[2][2];
#pragma unroll
                    for (int u = 0; u < 2; ++u) { f32x4 g0 = (f32x4){0.f, 0.f, 0.f, 0.f}, g1 = (f32x4){0.f, 0.f, 0.f, 0.f};
                        g0 = __builtin_amdgcn_mfma_f32_16x16x32_bf16(a00, cf[u][0], g0, 0, 0, 0); g0 = __builtin_amdgcn_mfma_f32_16x16x32_bf16(a01, cf[u][1], g0, 0, 0, 0);
                        g1 = __builtin_amdgcn_mfma_f32_16x16x32_bf16(a10, cf[u][0], g1, 0, 0, 0); g1 = __builtin_amdgcn_mfma_f32_16x16x32_bf16(a11, cf[u][1], g1, 0, 0, 0);
                        g[u][0] = g0; g[u][1] = g1; }
#pragma unroll
                    for (int u = 0; u < 2; ++u) { float mv[8]; const int l = lrow[u];
                        if (sp == ltp) {
#pragma unroll
                            for (int j = 0; j < 4; ++j) { const int s0 = sA + j, s1 = sB + j;
                                if (u == 0) { float m0 = (s0 <= l) ? g[u][0][j] * __expf(csl[u] - csa[j]) : 0.f; if (s0 == l) m0 += dsk[u]; mv[j] = m0; mv[4 + j] = 0.f; }
                                else { mv[j] = g[u][0][j] * __expf(csl[u] - csa[j]);
                                       float m1 = (s1 <= l) ? g[u][1][j] * __expf(csl[u] - csb[j]) : 0.f; if (s1 == l) m1 += dsk[u]; mv[4 + j] = m1; } }
                        } else {
                            const float el = __expf(csl[u] - csw[sp * 32 + 31]);
                            const f32x4 fa = *(const LAS f32x4*)(fsw + sA) * el, fb = *(const LAS f32x4*)(fsw + sB) * el;
#pragma unroll
                            for (int j = 0; j < 4; ++j) { mv[j] = g[u][0][j] * fa[j]; mv[4 + j] = g[u][1][j] * fb[j]; }
                        }
                        const bf16x8 mf = pack8(mv);
                        acc[u][0] = __builtin_amdgcn_mfma_f32_16x16x32_bf16(bx0, mf, acc[u][0], 0, 0, 0);
                        acc[u][1] = __builtin_amdgcn_mfma_f32_16x16x32_bf16(bx1, mf, acc[u][1], 0, 0, 0); }
                }
#pragma unroll
                for (int u = 0; u < 2; ++u) { const int lt = 2 * ltp + u; const f32x4 acc0 = acc[u][0], acc1 = acc[u][1]; const u32x2 z0 = zv[u][0], z1 = zv[u][1];
                  float s0, s1, s2, s3, s4, s5, s6, s7;
                  sigmoid2(bflo(z0.x), bfhi(z0.x), s0, s1); sigmoid2(bflo(z0.y), bfhi(z0.y), s2, s3); sigmoid2(bflo(z1.x), bfhi(z1.x), s4, s5); sigmoid2(bflo(z1.y), bfhi(z1.y), s6, s7);
                  const float y0 = acc0[0] * bflo(z0.x) * s0, y1 = acc0[1] * bfhi(z0.x) * s1, y2 = acc0[2] * bflo(z0.y) * s2, y3 = acc0[3] * bfhi(z0.y) * s3;
                  const float y4 = acc1[0] * bflo(z1.x) * s4, y5 = acc1[1] * bfhi(z1.x) * s5, y6 = acc1[2] * bflo(z1.y) * s6, y7 = acc1[3] * bfhi(z1.y) * s7;
                  bf16_t* zp = zl + (long)lt * 16 * PW;
                  u32x2 o0, o1; o0.x = cvt_pk_bf16(y0, y1); o0.y = cvt_pk_bf16(y2, y3); o1.x = cvt_pk_bf16(y4, y5); o1.y = cvt_pk_bf16(y6, y7);
                  *(u32x2*)zp = o0; *(u32x2*)(zp + 16) = o1;
                  float sq = (y0 * y0 + y1 * y1) + (y2 * y2 + y3 * y3) + (y4 * y4 + y5 * y5) + (y6 * y6 + y7 * y7);
                  sq += __shfl_xor(sq, 16); sq += __shfl_xor(sq, 32);
                  if (q == 0) { LAS float* rp = red + wid * 128 + lrow[u]; *rp = (ph == 0) ? sq : (*rp + sq); } }
            }
        }
        __syncthreads();
        {
            const float* nw = P->ssd_norm + layer * 1024 + h * 64; f32x4 nwv[4];
#pragma unroll
            for (int pt = 0; pt < 4; ++pt) nwv[pt] = *(const f32x4*)(nw + pt * 16 + q * 4);
#pragma unroll
            for (int lt = 0; lt < 8; ++lt) { const int l = lt * 16 + r; float t = 0.f;
#pragma unroll
                for (int w = 0; w < 8; ++w) t += red[w * 128 + l];
                const float rstd = rsqrtf(t * (1.f / 512.f) + EPS);
                bf16_t* zp = zbase + (long)l * PW + q * 4; u32x2 v[4];
#pragma unroll
                for (int pt = 0; pt < 4; ++pt) v[pt] = *(const u32x2*)(zp + pt * 16);
#pragma unroll
                for (int pt = 0; pt < 4; ++pt) { u32x2 o; o.x = cvt_pk_bf16(bflo(v[pt].x) * rstd * nwv[pt][0], bfhi(v[pt].x) * rstd * nwv[pt][1]);
                    o.y = cvt_pk_bf16(bflo(v[pt].y) * rstd * nwv[pt][2], bfhi(v[pt].y) * rstd * nwv[pt][3]); *(u32x2*)(zp + pt * 16) = o; }
                }
        }
    }
}

__device__ void phase_x1(KP P, int layer) {
    const int tid = opaque_tid(), lane = tid & 63; const int gw = blockIdx.x * 8 + (tid >> 6), nw = opaque_nblk() * 8;
    const bf16_t* xin = (const bf16_t*)(P->ws + OFF_XB); const bf16_t* mix = (const bf16_t*)P->out; const float* ssq2 = (const float*)(P->ws + OFF_SSQ2);
    float* ssq = (float*)(P->ws + OFF_SSQ);
    bf16_t* x1b = (bf16_t*)(P->ws + OFF_PROJ); const float* nwp = P->norm_post + layer * 1024;
    f32x4 wv[2][2];
#pragma unroll
    for (int i = 0; i < 2; ++i) { wv[i][0] = *(const f32x4*)(nwp + lane * 8 + 512 * i); wv[i][1] = *(const f32x4*)(nwp + lane * 8 + 512 * i + 4); }
#pragma unroll 8
    for (int row = gw; row < MTOK; row += nw) {
        const float rstd = rsqrtf(ssq2[row] * (1.f / 1024.f) + EPS);
        if (lane == 0) ssq[row] = 0.f;
#pragma unroll
        for (int i = 0; i < 2; ++i) { const size_t off = (size_t)row * 1024 + lane * 8 + 512 * i;
            float xv[8], mv[8]; unpack8(*(const u32x4*)(xin + off), xv); unpack8(__builtin_nontemporal_load((const u32x4*)(mix + off)), mv);
#pragma unroll
            for (int j = 0; j < 4; ++j) { xv[j] += mv[j] * rstd * wv[i][0][j]; xv[4 + j] += mv[4 + j] * rstd * wv[i][1][j]; }
            *(u32x4*)(x1b + off) = __builtin_bit_cast(u32x4, pack8(xv)); }
    }
}

#define XB_TMO      128
#define XB_XCNT(j)  (256  + 64 * (j))
#define XB_XSUB(j)  (1280 + 64 * (j))
#define XB_XGEN(j)  (2304 + 64 * (j))
#define XB_TOP      3328
#define XB_TOPGEN   3392
#define XCD_BAR_WORDS 3456
#define XB_SPIN_CAP (1u << 18)
__device__ __forceinline__ unsigned xb_ld(unsigned* p)              { return __hip_atomic_load(p, __ATOMIC_RELAXED, __HIP_MEMORY_SCOPE_AGENT); }
__device__ __forceinline__ unsigned xb_add(unsigned* p, unsigned v) { return __hip_atomic_fetch_add(p, v, __ATOMIC_RELAXED, __HIP_MEMORY_SCOPE_AGENT); }
__device__ __forceinline__ unsigned xb_xcc_id() { return (unsigned)__builtin_amdgcn_s_getreg((3 << 11) | 20) & 0xFu; }
#define XB_SPIN(cond, bar) do { unsigned _sp = 0; while (cond) { __builtin_amdgcn_s_sleep(1); \
    if ((++_sp & 255u) == 0u) { if (xb_ld(&(bar)[XB_TMO])) break; if (_sp > XB_SPIN_CAP) { atomicAdd(&(bar)[XB_TMO], 1u); break; } } } } while (0)
struct XcdBarrier { unsigned* bar; unsigned x; volatile LAS unsigned* st; };
__device__ __forceinline__ XcdBarrier xcd_barrier_post(unsigned* bar, volatile LAS unsigned* st) {
    XcdBarrier b; b.bar = bar; b.x = xb_xcc_id(); b.st = st;
    if (threadIdx.x == 0) (void)xb_add(&bar[XB_XCNT(b.x)], 1u);
    return b;
}
__device__ __forceinline__ void xcd_barrier_complete(unsigned* bar, unsigned x, unsigned& nloc, unsigned& nx) {
    const unsigned G = gridDim.x * gridDim.y * gridDim.z;
    unsigned sum, cnt, mine, sp = 0u;
    for (;;) {
        sum = 0u; cnt = 0u; mine = 0u;
#pragma unroll
        for (unsigned j = 0; j < 16; ++j) { const unsigned c = xb_ld(&bar[XB_XCNT(j)]); sum += c; cnt += (c > 0u) ? 1u : 0u; mine = (j == x) ? c : mine; }
        if (sum == G) break;
        __builtin_amdgcn_s_sleep(1);
        if ((++sp & 255u) == 0u) { if (xb_ld(&bar[XB_TMO])) break; if (sp > XB_SPIN_CAP) { atomicAdd(&bar[XB_TMO], 1u); break; } }
    }
    nloc = mine > 0u ? mine : 1u; nx = cnt > 0u ? cnt : 1u;
}
__device__ __forceinline__ void xcd_barrier(const XcdBarrier& b) {
    asm volatile("s_waitcnt vmcnt(0)" ::: "memory");
    __syncthreads();
    if (threadIdx.x == 0) {
        unsigned* bar = b.bar; asm volatile("" : "+s"(bar));
        __builtin_amdgcn_s_waitcnt(0);
        unsigned nloc = b.st[0], nx = b.st[1];
        if (nloc == 0u) { xcd_barrier_complete(bar, b.x, nloc, nx); b.st[0] = nloc; b.st[1] = nx; }
        const unsigned old = xb_add(&bar[XB_XSUB(b.x)], 1u);
        const unsigned gen = old / nloc;
        if (old + 1u == (gen + 1u) * nloc) {
            __builtin_amdgcn_fence(__ATOMIC_RELEASE, "agent");
            asm volatile("s_waitcnt vmcnt(0)" ::: "memory");
            const unsigned og = xb_add(&bar[XB_TOP], 1u);
            const unsigned tg = og / nx;
            if (og + 1u == (tg + 1u) * nx) xb_add(&bar[XB_TOPGEN], 1u);
            else XB_SPIN(xb_ld(&bar[XB_TOPGEN]) == tg, bar);
            __builtin_amdgcn_fence(__ATOMIC_ACQUIRE, "agent");
            xb_add(&bar[XB_XGEN(b.x)], 1u);
            asm volatile("s_waitcnt vmcnt(0)" ::: "memory");
        } else {
            XB_SPIN(xb_ld(&bar[XB_XGEN(b.x)]) == gen, bar);
            __builtin_amdgcn_fence(__ATOMIC_ACQUIRE, "agent");
            asm volatile("s_waitcnt vmcnt(0)" ::: "memory");
        }
    }
    __syncthreads();
}

__global__ void __launch_bounds__(512, 2) fwd_megakernel(Params Pval) {
    (void)Pval;
    extern __shared__ __attribute__((aligned(16))) unsigned char shm[];
    LAS unsigned char* lds = (LAS unsigned char*)shm;
    cg::grid_group grid = cg::this_grid();
    pg8::StaticOrder S;
    const int ph_lo = kernarg_params()->ph_lo, ph_hi = kernarg_params()->ph_hi;
    unsigned char* ws0 = kernarg_params()->ws;
    volatile LAS unsigned* stw = (volatile LAS unsigned*)(lds + LDS_BYTES - 16);
    if (threadIdx.x == 0) { stw[0] = 0u; stw[1] = 0u; }
    __syncthreads();
    const XcdBarrier xbar = xcd_barrier_post((unsigned*)(ws0 + OFF_BAR), stw);
    int rep = 0; (void)rep;
    for (int ph = ph_lo; ph < ph_hi; ++ph) {
        const KP P = kernarg_params(); unsigned char* ws = P->ws;
        if (ph == 0) phase_prologue(P, lds);
        else {
            const int layer = (ph - 1) / 7, sub = (ph - 1) % 7;
            if (sub == 0 || sub == 4 || sub == 6) {
                const int ngi = (sub == 0) ? 2 : 1;
                for (int gi = 0; gi < ngi; ++gi) {
                    pg8::Gemm g; EpiAll E{0, layer, ws, P->out};
                    if (sub == 0 && gi == 0) {
                        g = pg8::Gemm{(const bf16_t*)(ws + OFF_XB), (const bf16_t*)(ws + OFF_BTIN) + (size_t)layer * NIN * 1024, MTOK, NIN, 1024, 1024};
                        E.mode = 0;
                    } else if (sub == 0) {
                        g = pg8::Gemm{(const bf16_t*)(ws + OFF_PB) + (size_t)layer * MTOK * 256, (const bf16_t*)(ws + OFF_BTP) + (size_t)layer * 1024 * 256, MTOK, 1024, 256, 256};
                        E.mode = 1;
                    } else if (sub == 4) {
                        g = pg8::Gemm{(const bf16_t*)(ws + OFF_PROJ) + COL_Z, (const bf16_t*)(ws + OFF_BTOUT) + (size_t)layer * 1024 * 2048, MTOK, 1024, 2048, PW};
                        E.mode = 2;
                    } else {
                        g = pg8::Gemm{(const bf16_t*)(ws + OFF_PROJ), (const bf16_t*)(ws + OFF_BTG) + (size_t)layer * 1024 * 1024, MTOK, 1024, 1024, 1024};
                        E.mode = 3;
                    }
                    S.init(g.M, g.N, opaque_nblk(), blockIdx.x); pg8::gemm_phase(lds, g, S, E);
                }
            } else if (sub == 1) phase_states(P, layer, lds);
            else if (sub == 2) phase_scan_sc(P, layer);
            else if (sub == 3) phase_ssd_out(P, layer, lds);
            else phase_x1(P, layer);
        }
        if (ph + 1 < ph_hi) { if (ph_lo != 0) grid.sync(); else xcd_barrier(xbar); }
#ifdef DBL_SUB
        if (ph > 0 && (ph - 1) % 7 == DBL_SUB && !rep) { rep = 1; --ph; } else rep = 0;
#endif
    }
}

extern "C" void kernel_launch(void* const* d_in, const int* in_sizes, int n_in, void* d_out, int out_size, void* d_ws, size_t ws_size, hipStream_t stream) {
    static int grid_blocks = 0;
    if (grid_blocks == 0) {
        if (n_in != 15 || ws_size < WS_END) { fprintf(stderr, "kernel_launch: need 15 inputs and %zu bytes of workspace (got %d, %zu)\n", (size_t)WS_END, n_in, ws_size); grid_blocks = -1; return; }
        int dev = 0, cus = 0, per_cu = 0;
        hipGetDevice(&dev); hipDeviceGetAttribute(&cus, hipDeviceAttributeMultiprocessorCount, dev);
        if (hipFuncSetAttribute((const void*)fwd_megakernel, hipFuncAttributeMaxDynamicSharedMemorySize, LDS_BYTES) != hipSuccess) { fprintf(stderr, "kernel_launch: hipFuncSetAttribute failed\n"); grid_blocks = -1; return; }
        if (hipOccupancyMaxActiveBlocksPerMultiprocessor(&per_cu, (const void*)fwd_megakernel, 512, LDS_BYTES) != hipSuccess || per_cu < 1) per_cu = 1;
        (void)hipGetLastError();
        grid_blocks = cus * 1;
        if (grid_blocks <= 0) grid_blocks = 256;
    }
    if (grid_blocks < 0) return;
    Params P{};
    P.x = (const float*)d_in[0]; P.p = (const float*)d_in[1]; P.norm_pre = (const float*)d_in[2]; P.norm_post = (const float*)d_in[3]; P.w_in = (const float*)d_in[4];
    P.conv_w = (const float*)d_in[5]; P.conv_b = (const float*)d_in[6]; P.dt_bias = (const float*)d_in[7]; P.a_log = (const float*)d_in[8]; P.d_skip = (const float*)d_in[9];
    P.ssd_norm = (const float*)d_in[10]; P.sc_w = (const float*)d_in[11]; P.w_out = (const float*)d_in[12]; P.w_g = (const float*)d_in[13]; P.w_p = (const float*)d_in[14];
    P.out = (float*)d_out; P.ws = (unsigned char*)d_ws;
    (void)hipMemsetAsync((unsigned char*)d_ws + OFF_BAR, 0, XCD_BAR_WORDS * 4, stream);
    P.ph_lo = 0; P.ph_hi = 15;
    void* args[] = {&P};
    hipError_t e = hipLaunchCooperativeKernel((const void*)fwd_megakernel, dim3(grid_blocks), dim3(512), args, LDS_BYTES, stream);
    if (e != hipSuccess) fprintf(stderr, "cooperative launch failed: %s (grid %d)\n", hipGetErrorString(e), grid_blocks);
}
```
